# Optimizing an MI355X kernel written in HIP

```python
import jax, jax.numpy as jnp
from jax import lax
import numpy as np

D_MODEL = 2048
BATCH = 16
SEQ = 2048
DEPTH = 1

GRID_W = 64
CTX_LEN = 256
NA_HEADS = 8
NA_HEAD_DIM = 128
NA_WIN_H_MAX = 8
NA_WIN_W = 16
RET_HEADS = 8
RET_QK_DIM = 64
RET_V_DIM = 128
RET_CHUNK = 128
NA_WIDTH = NA_HEADS * NA_HEAD_DIM
RET_QK_WIDTH = RET_HEADS * RET_QK_DIM
RET_V_WIDTH = RET_HEADS * RET_V_DIM
MIX_WIDTH = NA_WIDTH + RET_V_WIDTH
IN_WIDTH = 3 * NA_WIDTH + 2 * RET_QK_WIDTH + 2 * RET_V_WIDTH
D_FF = -(-8 * D_MODEL // (3 * 256)) * 256
ROPE_BASE = 10000.0
EPS = 1e-6

kernel_name = 'hybrid_na_retention_dit_block'


def rms_norm(x, g):
    xf = x.astype(jnp.float32)
    y = xf * lax.rsqrt(jnp.mean(xf * xf, axis=-1, keepdims=True) + EPS)
    return (y * g.astype(jnp.float32)).astype(x.dtype)


def adaln(cvec, ada_w, ada_b):
    m = jax.nn.silu(cvec) @ ada_w + ada_b
    return jnp.split(m, 6, axis=-1)


def modulate(x, g, shift, scale):
    return rms_norm(x, g) * (1 + scale) + shift


def split_projection(p):
    B, L, _ = p.shape
    sizes = [NA_WIDTH, NA_WIDTH, NA_WIDTH, RET_QK_WIDTH, RET_QK_WIDTH, RET_V_WIDTH]
    offs = np.cumsum(sizes).tolist()
    na_q, na_k, na_v, r_q, r_k, r_v, r_g = jnp.split(p, offs, axis=-1)
    heads = lambda t, h: t.reshape(B, L, h, -1).transpose(0, 2, 1, 3)
    return (heads(na_q, NA_HEADS), heads(na_k, NA_HEADS), heads(na_v, NA_HEADS),
            heads(r_q, RET_HEADS), heads(r_k, RET_HEADS), heads(r_v, RET_HEADS), r_g)


def axial_rope(x, pos_row, pos_col):
    d = x.shape[-1]
    half = d // 2
    quarter = half // 2
    inv_freq = ROPE_BASE ** (-jnp.arange(quarter, dtype=jnp.float32) / quarter)

    def rot(xa, pos):
        ang = pos.astype(jnp.float32)[:, None] * inv_freq
        cos, sin = jnp.cos(ang), jnp.sin(ang)
        x1 = xa[..., :quarter].astype(jnp.float32)
        x2 = xa[..., quarter:].astype(jnp.float32)
        return jnp.concatenate([x1 * cos - x2 * sin, x1 * sin + x2 * cos], axis=-1)

    out = jnp.concatenate([rot(x[..., :half], pos_row), rot(x[..., half:], pos_col)], axis=-1)
    return out.astype(x.dtype)


def neighbourhood_attention(q, k, v, k_ctx, v_ctx, rpb):
    B, H, rows, W, d = q.shape
    win_h = min(NA_WIN_H_MAX, rows)
    n_loc = win_h * NA_WIN_W
    scale = d ** -0.5
    cols = jnp.arange(W)
    col_start = jnp.clip(cols - NA_WIN_W // 2, 0, W - NA_WIN_W)
    col_idx = col_start[:, None] + jnp.arange(NA_WIN_W)[None, :]
    dc = col_idx - cols[:, None]

    def row_block(r):
        rs = jnp.clip(r - win_h // 2, 0, rows - win_h)
        q_r = lax.dynamic_index_in_dim(q, r, axis=2, keepdims=False)
        k_band = lax.dynamic_slice_in_dim(k, rs, win_h, axis=2)
        v_band = lax.dynamic_slice_in_dim(v, rs, win_h, axis=2)
        k_win = k_band[:, :, :, col_idx]
        v_win = v_band[:, :, :, col_idx]
        dr = rs + jnp.arange(win_h) - r
        bias = rpb[:, dr[None, :, None] + NA_WIN_H_MAX - 1, dc[:, None, :] + NA_WIN_W - 1]
        s_loc = jnp.einsum('bhqd,bhiqjd->bhqij', q_r, k_win).astype(jnp.float32) * scale
        s_loc = (s_loc + bias.astype(jnp.float32)[None]).reshape(B, H, W, n_loc)
        s_ctx = jnp.einsum('bhqd,bhkd->bhqk', q_r, k_ctx).astype(jnp.float32) * scale
        p = jax.nn.softmax(jnp.concatenate([s_loc, s_ctx], axis=-1), axis=-1).astype(v.dtype)
        p_loc = p[..., :n_loc].reshape(B, H, W, win_h, NA_WIN_W)
        p_ctx = p[..., n_loc:]
        return (jnp.einsum('bhqij,bhiqjd->bhqd', p_loc, v_win)
                + jnp.einsum('bhqk,bhkd->bhqd', p_ctx, v_ctx))

    out = lax.map(row_block, jnp.arange(rows))
    return jnp.moveaxis(out, 0, 2).reshape(B, H, rows * W, d)


def context_attention(q, k, v):
    s = jnp.einsum('bhqd,bhkd->bhqk', q, k).astype(jnp.float32) * q.shape[-1] ** -0.5
    p = jax.nn.softmax(s, axis=-1).astype(v.dtype)
    return jnp.einsum('bhqk,bhkd->bhqd', p, v)


def retention_chunkwise(q, k, v, log_gamma, s0):
    B, H, L, dk = q.shape
    dv = v.shape[-1]
    C = RET_CHUNK
    n = L // C
    lg = log_gamma.astype(jnp.float32)
    idx = jnp.arange(C, dtype=jnp.float32)
    diff = idx[:, None] - idx[None, :]
    decay_in = jnp.where(diff >= 0, jnp.exp(lg[:, None, None] * jnp.maximum(diff, 0.0)), 0.0)
    decay_q = jnp.exp(lg[:, None] * (idx + 1.0))[..., None]
    decay_k = jnp.exp(lg[:, None] * (C - 1.0 - idx))[..., None]
    decay_chunk = jnp.exp(lg * C)[:, None, None]

    def chunks(t):
        return jnp.moveaxis(t.astype(jnp.float32).reshape(B, H, n, C, t.shape[-1]), 2, 0)

    qs, ks, vs = chunks(q * dk ** -0.5), chunks(k), chunks(v)

    def step(s, inp):
        qc, kc, vc = inp
        inner = jnp.einsum('bhid,bhjd->bhij', qc, kc) * decay_in
        o = (jnp.einsum('bhij,bhjv->bhiv', inner, vc)
             + jnp.einsum('bhid,bhdv->bhiv', qc * decay_q, s))
        s_new = s * decay_chunk + jnp.einsum('bhjd,bhjv->bhdv', kc * decay_k, vc)
        return s_new, o

    s_fin, o = lax.scan(step, s0, (qs, ks, vs))
    o = jnp.moveaxis(o, 0, 2).reshape(B, H, L, dv).astype(v.dtype)
    return o, s_fin


def merge_mixers(o_na, o_ret, r_g, w_out):
    B, _, L, _ = o_na.shape
    of = o_ret.astype(jnp.float32)
    mu = jnp.mean(of, axis=-1, keepdims=True)
    var = jnp.mean(jnp.square(of - mu), axis=-1, keepdims=True)
    o_ret_n = ((of - mu) * lax.rsqrt(var + EPS)).astype(o_ret.dtype)
    na = o_na.transpose(0, 2, 1, 3).reshape(B, L, NA_WIDTH)
    ret = o_ret_n.transpose(0, 2, 1, 3).reshape(B, L, RET_V_WIDTH) * jax.nn.silu(r_g)
    return jnp.concatenate([na, ret], axis=-1) @ w_out


def swiglu(h, w_gate, w_up, w_down):
    return (jax.nn.silu(h @ w_gate) * (h @ w_up)) @ w_down


def setup_inputs(seed: int = 0) -> dict:
    key = jax.random.key(seed)
    ks = jax.random.split(key, 18)
    f32 = jnp.float32

    def nrm(k, shape, scale):
        return jax.random.normal(k, shape, f32) * scale

    base_lg = jnp.log1p(-jnp.exp2(-5.0 - jnp.arange(RET_HEADS, dtype=f32)))
    return {
        'x': nrm(ks[0], (BATCH, SEQ, D_MODEL), 1.0),
        'c': nrm(ks[1], (BATCH, D_MODEL), 1.0),
        'ctx': nrm(ks[2], (BATCH, CTX_LEN, D_MODEL), 1.0),
        'c_ctx': nrm(ks[3], (D_MODEL,), 1.0),
        'ada_w': nrm(ks[4], (DEPTH, D_MODEL, 6 * D_MODEL), 0.5 * D_MODEL ** -0.5),
        'ada_b': nrm(ks[5], (DEPTH, 6 * D_MODEL), 0.02),
        'norm_pre_mix': 1.0 + nrm(ks[6], (DEPTH, D_MODEL), 0.05),
        'norm_post_mix': 1.0 + nrm(ks[7], (DEPTH, D_MODEL), 0.05),
        'norm_pre_ffn': 1.0 + nrm(ks[8], (DEPTH, D_MODEL), 0.05),
        'norm_post_ffn': 1.0 + nrm(ks[9], (DEPTH, D_MODEL), 0.05),
        'w_in': nrm(ks[10], (DEPTH, D_MODEL, IN_WIDTH), D_MODEL ** -0.5),
        'na_rpb': nrm(ks[11], (DEPTH, NA_HEADS, 2 * NA_WIN_H_MAX - 1, 2 * NA_WIN_W - 1), 0.1),
        'ret_log_gamma_fwd': base_lg * (1.0 + nrm(ks[12], (DEPTH, RET_HEADS), 0.05)),
        'ret_log_gamma_bwd': base_lg * (1.0 + nrm(ks[13], (DEPTH, RET_HEADS), 0.05)),
        'w_out': nrm(ks[14], (DEPTH, MIX_WIDTH, D_MODEL), MIX_WIDTH ** -0.5),
        'w_gate': nrm(ks[15], (DEPTH, D_MODEL, D_FF), D_MODEL ** -0.5),
        'w_up': nrm(ks[16], (DEPTH, D_MODEL, D_FF), D_MODEL ** -0.5),
        'w_down': nrm(ks[17], (DEPTH, D_FF, D_MODEL), D_FF ** -0.5),
    }


def reference(x, c, ctx, c_ctx, ada_w, ada_b, norm_pre_mix, norm_post_mix, norm_pre_ffn,
              norm_post_ffn, w_in, na_rpb, ret_log_gamma_fwd, ret_log_gamma_bwd, w_out,
              w_gate, w_up, w_down):
    B, L, _ = x.shape
    rows = L // GRID_W
    t = jnp.arange(L)
    pos_row, pos_col = t // GRID_W, t % GRID_W
    flip = lambda a: jnp.flip(a, axis=2)
    grid = lambda a: a.reshape(B, NA_HEADS, rows, GRID_W, NA_HEAD_DIM)
    zero_state = jnp.zeros((B, RET_HEADS, RET_QK_DIM, RET_V_DIM), jnp.float32)

    for li in range(DEPTH):
        sh1, sc1, g1, sh2, sc2, g2 = [m[:, None, :] for m in adaln(c, ada_w[li], ada_b[li])]
        csh1, csc1, cg1, csh2, csc2, cg2 = adaln(c_ctx, ada_w[li], ada_b[li])

        h = modulate(x, norm_pre_mix[li], sh1, sc1)
        hc = modulate(ctx, norm_pre_mix[li], csh1, csc1)
        na_q, na_k, na_v, r_q, r_k, r_v, r_g = split_projection(h @ w_in[li])
        cna_q, cna_k, cna_v, cr_q, cr_k, cr_v, cr_g = split_projection(hc @ w_in[li])

        o_na = neighbourhood_attention(grid(na_q), grid(na_k), grid(na_v), cna_k, cna_v, na_rpb[li])

        o_cf, s_cf = retention_chunkwise(cr_q, cr_k, cr_v, ret_log_gamma_fwd[li], zero_state)
        o_cb, s_cb = retention_chunkwise(flip(cr_q), flip(cr_k), flip(cr_v), ret_log_gamma_bwd[li], zero_state)
        rq = axial_rope(r_q, pos_row, pos_col)
        rk = axial_rope(r_k, pos_row, pos_col)
        o_f, _ = retention_chunkwise(rq, rk, r_v, ret_log_gamma_fwd[li], s_cf)
        o_b, _ = retention_chunkwise(flip(rq), flip(rk), flip(r_v), ret_log_gamma_bwd[li], s_cb)
        o_ret = o_f + flip(o_b)

        mix = merge_mixers(o_na, o_ret, r_g, w_out[li])
        x_new = x + g1 * rms_norm(mix, norm_post_mix[li])
        h2 = modulate(x_new, norm_pre_ffn[li], sh2, sc2)
        x_new = x_new + g2 * rms_norm(swiglu(h2, w_gate[li], w_up[li], w_down[li]), norm_post_ffn[li])

        if li + 1 < DEPTH:
            o_na_c = context_attention(cna_q, cna_k, cna_v)
            o_ret_c = o_cf + flip(o_cb)
            mix_c = merge_mixers(o_na_c, o_ret_c, cr_g, w_out[li])
            ctx = ctx + cg1 * rms_norm(mix_c, norm_post_mix[li])
            hc2 = modulate(ctx, norm_pre_ffn[li], csh2, csc2)
            ctx = ctx + cg2 * rms_norm(swiglu(hc2, w_gate[li], w_up[li], w_down[li]), norm_post_ffn[li])
        x = x_new
    return x
```

```cpp
#include <hip/hip_runtime.h>
#include <hip/hip_cooperative_groups.h>
#include <cstdio>
#include <cstdint>
namespace cg = cooperative_groups;
namespace pg8 {
#define PG8_LAS __attribute__((address_space(3)))
typedef unsigned short bf16_t;
typedef short bf16x8 __attribute__((ext_vector_type(8)));
typedef float f32x4 __attribute__((ext_vector_type(4)));
typedef unsigned u32x4 __attribute__((ext_vector_type(4)));
constexpr int BM = 256, BK = 64, HALF = 128, HTB = HALF * BK * 2  , STAGE_BYTES = 8 * HTB, NXCD = 8, WGM = 8;

__host__ __device__ __forceinline__ int lds_byte(int r, int c) { const int st = (r >> 4) * 2 + (c >> 5), rr = r & 15, cc = c & 31, ob = rr * 64 + cc * 2; return st * 1024 + (ob ^ (((ob >> 9) & 1) << 5)); }
__host__ __device__ __forceinline__ void stage_rc(int b, int& R, int& C) { const int st = b / 1024, sb = b % 1024, swz = sb ^ (((sb >> 9) & 1) << 5); R = (st >> 1) * 16 + swz / 64; C = (st & 1) * 32 + (swz % 64) / 2; }
__host__ __device__ __forceinline__ int perm32(int rho) { const int n = rho >> 4, i = rho & 15; return 8 * (i >> 2) + 4 * n + (i & 3); }

struct Unit { int pm, pn; };
struct Gemm { const bf16_t* A; const bf16_t* Bt; int M, N, K, ld; };

struct StaticOrder {
    int nM, nN, nwg, G, c;
    __host__ __device__ void init(int M, int N, int G_, int c_) { nM = M / BM; nN = N / BM; nwg = nM * nN; G = G_; c = c_; }
    __host__ __device__ bool next(int i, Unit& u) const {
        const long L = (long)i * G + c; if (L >= nwg) return false;
        int wgid = (int)L; { const int q = nwg / NXCD, r = nwg % NXCD, xcd = wgid % NXCD, off = wgid / NXCD; wgid = (xcd < r ? xcd * (q + 1) : r * (q + 1) + (xcd - r) * q) + off; }
        const int nig = WGM * nN, gid = wgid / nig, fm = gid * WGM, gsz = (nM - fm) < WGM ? (nM - fm) : WGM;
        u.pm = fm + ((wgid % nig) % gsz); u.pn = (wgid % nig) / gsz; return true;
    }
    __device__ __forceinline__ void a_ready(const Unit&) const {}
    __device__ __forceinline__ void done(const Unit&) const {}
};

__device__ __forceinline__ unsigned cvt_pk_bf16(float lo, float hi) { unsigned r; asm volatile("v_cvt_pk_bf16_f32 %0, %1, %2" : "=v"(r) : "v"(lo), "v"(hi)); return r; }
typedef unsigned u32x2 __attribute__((ext_vector_type(2)));
typedef float f32x2 __attribute__((ext_vector_type(2)));
#define PG8_GAS __attribute__((address_space(1)))
constexpr int PWP = 3072 + 64;

template <int MODE, int GM = WGM, bool REV = false> struct GridOrder {
    int nM, nS, G, c;
    __device__ __forceinline__ void init(int nM_, int nS_, int G_, int c_) { nM = nM_; nS = nS_; G = G_; c = c_; }
    __device__ __forceinline__ bool next(int i, Unit& u) const {
        const int nwg = nM * nS; const int nr = (nwg + G - 1) / G; if (REV && i >= nr) return false; const long L = (long)(REV ? nr - 1 - i : i) * G + c; int pm, s;
        if (L < nwg) {
            int wgid = (int)L; { const int q = nwg / NXCD, r = nwg % NXCD, xcd = wgid % NXCD, off = wgid / NXCD; wgid = (xcd < r ? xcd * (q + 1) : r * (q + 1) + (xcd - r) * q) + off; }
            const int nig = GM * nS, gid = wgid / nig, fm = gid * GM, gsz = (nM - fm) < GM ? (nM - fm) : GM;
            pm = fm + ((wgid % nig) % gsz); s = (wgid % nig) / gsz;
            if (MODE == 2) s = s < 4 ? s + 8 : s + 12;
        } else if (MODE == 1 && L < nwg + 224) {
            const int l2 = (int)(L - nwg); pm = 128 + (l2 & 15); s = l2 >> 4; s = s < 8 ? s + 4 : s + 6;
        } else return false;
        u.pm = pm; u.pn = s; return true;
    }
    __device__ __forceinline__ void a_ready(const Unit&) const {}
    __device__ __forceinline__ void done(const Unit&) const {}
};

__device__ __forceinline__ float silu_f(float g) { return g * __builtin_amdgcn_rcpf(1.0f + __builtin_amdgcn_exp2f(-1.44269504089f * g)); }

struct EpiPlain {
    static constexpr bool PERM = true, AFTER_DRAIN = false;
    bf16_t* O; int ldc;
    __device__ __forceinline__ void operator()(const f32x4 (&acc)[2][2][4][2], const Unit& u, int wr, int wc, int fr, int fq) const {
        const int row0 = u.pm * BM + wr * 64 + fr, col0 = u.pn * BM + wc * 32 + 8 * fq;
#pragma unroll
        for (int ai = 0; ai < 2; ++ai)
#pragma unroll
            for (int m = 0; m < 4; ++m) { bf16_t* rowp = O + (size_t)(row0 + ai * HALF + m * 16) * ldc + col0;
#pragma unroll
                for (int bj = 0; bj < 2; ++bj) { const f32x4 v0 = acc[ai][bj][m][0], v1 = acc[ai][bj][m][1];
                    u32x4 w; w.x = cvt_pk_bf16(v0[0], v0[1]); w.y = cvt_pk_bf16(v0[2], v0[3]); w.z = cvt_pk_bf16(v1[0], v1[1]); w.w = cvt_pk_bf16(v1[2], v1[3]);
                    *(PG8_GAS u32x4*)(rowp + bj * HALF) = w; } }
    }
};

struct EpiSwiglu {
    static constexpr bool PERM = true, AFTER_DRAIN = false;
    bf16_t* O; int ldc;
    __device__ __forceinline__ void operator()(const f32x4 (&acc)[2][2][4][2], const Unit& u, int wr, int wc, int fr, int fq) const {
        const int row0 = u.pm * BM + wr * 64 + fr, col0 = u.pn * HALF + wc * 32 + 8 * fq;
#pragma unroll
        for (int ai = 0; ai < 2; ++ai)
#pragma unroll
            for (int m = 0; m < 4; ++m) { bf16_t* rowp = O + (size_t)(row0 + ai * HALF + m * 16) * ldc + col0;
                const f32x4 g0 = acc[ai][0][m][0], g1 = acc[ai][0][m][1], u0 = acc[ai][1][m][0], u1 = acc[ai][1][m][1];
                float h[8];
#pragma unroll
                for (int e = 0; e < 4; ++e) { h[e] = silu_f(g0[e]) * u0[e]; h[4 + e] = silu_f(g1[e]) * u1[e]; }
                u32x4 w; w.x = cvt_pk_bf16(h[0], h[1]); w.y = cvt_pk_bf16(h[2], h[3]); w.z = cvt_pk_bf16(h[4], h[5]); w.w = cvt_pk_bf16(h[6], h[7]);
                *(PG8_GAS u32x4*)rowp = w; }
    }
};

struct EpiIn {
    static constexpr bool PERM = true, AFTER_DRAIN = false;
    bf16_t* P; const f32x2* rope;
    bf16_t* Vt; bf16_t* Vtc;
    bf16_t* Kn; bf16_t* Knc;
    __device__ __forceinline__ void store_vt(const f32x4 (&acc)[2][2][4][2], const Unit& u, int wr, int wc, int fr, int fq) const {
        const int which = u.pn >= 16 ? 1 : 0, j = fr & 3, odd = j & 1, hi2 = (j >> 1) & 1;
        const int cb0 = (u.pn - (which ? 16 : 8)) * BM + wc * 32 + 8 * fq + (odd ? 4 : 0) + (hi2 ? 2 : 0);
        const bool lat = u.pm < 128;
#pragma unroll
        for (int ai = 0; ai < 2; ++ai)
#pragma unroll
            for (int m = 0; m < 4; ++m) { const int row = u.pm * BM + ai * HALF + wr * 64 + m * 16 + (fr & ~3);
                int b, t, ng; bf16_t* base;
                if (lat) { b = row >> 11; t = row & 2047; ng = 256; base = Vt; } else { const int r2 = row - 32768; b = r2 >> 8; t = r2 & 255; ng = 32; base = Vtc; }
#pragma unroll
                for (int bj = 0; bj < 2; ++bj) { float v[8];
#pragma unroll
                    for (int e = 0; e < 4; ++e) { v[e] = acc[ai][bj][m][0][e]; v[4 + e] = acc[ai][bj][m][1][e]; }
                    unsigned pr[4];
#pragma unroll
                    for (int i = 0; i < 4; ++i) { const float snd = odd ? v[i] : v[4 + i]; const float rcv = __shfl_xor(snd, 1);
                        pr[i] = odd ? cvt_pk_bf16(rcv, v[4 + i]) : cvt_pk_bf16(v[i], rcv); }
#pragma unroll
                    for (int k = 0; k < 2; ++k) { const unsigned snd = hi2 ? pr[k] : pr[2 + k]; const unsigned rcv = (unsigned)__shfl_xor((int)snd, 2);
                        u32x2 w; w.x = hi2 ? rcv : pr[k]; w.y = hi2 ? pr[2 + k] : rcv;
                        const int vcol = cb0 + bj * HALF + k; const int head = vcol >> 7, vd = vcol & 127;
                        *(PG8_GAS u32x2*)((PG8_GAS char*)base + ((size_t)(which * 128 + b * 8 + head) * ng + (t >> 3)) * 2048 + vd * 16 + (t & 7) * 2) = w; } } }
    }
    __device__ __forceinline__ void store_kn(const f32x4 (&acc)[2][2][4][2], const Unit& u, int wr, int wc, int fr, int fq) const {
        const bool lat = u.pm < 128;
#pragma unroll
        for (int ai = 0; ai < 2; ++ai)
#pragma unroll
            for (int m = 0; m < 4; ++m) { const int row = u.pm * BM + ai * HALF + wr * 64 + m * 16 + fr;
                int b, t, ng; bf16_t* base;
                if (lat) { b = row >> 11; t = row & 2047; ng = 256; base = Kn; } else { const int r2 = row - 32768; b = r2 >> 8; t = r2 & 255; ng = 32; base = Knc; }
#pragma unroll
                for (int bj = 0; bj < 2; ++bj) { const int head = (u.pn - 4) * 2 + bj; const f32x4 v0 = acc[ai][bj][m][0], v1 = acc[ai][bj][m][1];
                    u32x4 w; w.x = cvt_pk_bf16(v0[0], v0[1]); w.y = cvt_pk_bf16(v0[2], v0[3]); w.z = cvt_pk_bf16(v1[0], v1[1]); w.w = cvt_pk_bf16(v1[2], v1[3]);
                    *(PG8_GAS u32x4*)((PG8_GAS char*)base + ((size_t)(b * 8 + head) * ng + (t >> 3)) * 2048 + wc * 512 + (t & 7) * 64 + fq * 16) = w; } }
    }
    __device__ __forceinline__ void operator()(const f32x4 (&acc)[2][2][4][2], const Unit& u, int wr, int wc, int fr, int fq) const {
        if ((u.pn >= 8 && u.pn < 12) || (u.pn >= 16 && u.pn < 20)) { store_vt(acc, u, wr, wc, fr, fq); return; }
        if (u.pn >= 4 && u.pn < 8) { store_kn(acc, u, wr, wc, fr, fq); return; }
        const int pn = u.pn, slot = pn < 4 ? pn : (pn < 16 ? pn - 8 : pn - 12);
        const int row0 = u.pm * BM + wr * 64 + fr, col0 = slot * BM + wc * 32 + 8 * fq;
        const bool do_rope = (pn >= 12) && (pn < 16) && (u.pm < 128);
        const float qs = (pn == 12 || pn == 13) ? 0.125f : 1.0f;
        const float sgn = fq < 2 ? -1.0f : 1.0f;
#pragma unroll
        for (int ai = 0; ai < 2; ++ai)
#pragma unroll
            for (int m = 0; m < 4; ++m) { const int row = row0 + ai * HALF + m * 16; bf16_t* rowp = P + (size_t)row * PWP + col0;
                const int t = row & 2047, pos = (wc & 1) ? (t & 63) : (t >> 6);
                const PG8_GAS f32x4* rp = (const PG8_GAS f32x4*)(rope + pos * 16 + 8 * (fq & 1));
#pragma unroll
                for (int bj = 0; bj < 2; ++bj) { float v[8];
#pragma unroll
                    for (int e = 0; e < 4; ++e) { v[e] = acc[ai][bj][m][0][e]; v[4 + e] = acc[ai][bj][m][1][e]; }
                    if (do_rope) {
#pragma unroll
                        for (int e2 = 0; e2 < 4; ++e2) { const f32x4 cs = rp[e2];
                            const float p0 = __shfl_xor(v[2 * e2], 32), p1 = __shfl_xor(v[2 * e2 + 1], 32);
                            v[2 * e2] = v[2 * e2] * cs[0] + sgn * p0 * cs[1]; v[2 * e2 + 1] = v[2 * e2 + 1] * cs[2] + sgn * p1 * cs[3]; }
                    }
                    u32x4 w; w.x = cvt_pk_bf16(v[0] * qs, v[1] * qs); w.y = cvt_pk_bf16(v[2] * qs, v[3] * qs); w.z = cvt_pk_bf16(v[4] * qs, v[5] * qs); w.w = cvt_pk_bf16(v[6] * qs, v[7] * qs);
                    *(PG8_GAS u32x4*)(rowp + bj * HALF) = w; } }
    }
};

template <class Epi, class Sched, bool ALIGN_EPI = false, bool SP2 = false, bool TR = false>
__device__ __forceinline__ void gemm_phase(PG8_LAS unsigned char* lds, const Gemm g, const Sched& S, const Epi& E) {
    int tid_ = threadIdx.x; asm volatile("" : "+v"(tid_));
    const int tid = tid_, wid = __builtin_amdgcn_readfirstlane(tid >> 6), lane = tid & 63, wr = wid >> 2, wc = wid & 3, fr = lane & 15, fq = lane >> 4;
    const int K = g.K, nt = K / BK;
    unsigned voffA[2], voffB[2];
#pragma unroll
    for (int i = 0; i < 2; ++i) { int R, C; stage_rc(tid * 16 + i * 8192, R, C); const int Rb = Epi::PERM ? ((R & ~31) + perm32(R & 31)) : R;
        voffA[i] = (unsigned)(R * g.ld + C) * 2u; voffB[i] = (unsigned)(Rb * g.ld + C) * 2u; }
    const size_t kstep = (size_t)(BK * 2);
    const size_t hstep = (size_t)HALF * g.ld * 2;
    const size_t tstep = 2 * hstep;
    const unsigned ldsw = (unsigned)wid * 1024u;
    const int aoff = lds_byte(wr * 64 + fr, fq * 8), boff = lds_byte(wc * 32 + fr, fq * 8);
#define PG8_SA(b, h) (((b) * 2 + (h)) * HTB)
#define PG8_SB(b, h) ((4 + (b) * 2 + (h)) * HTB)
#define PG8_STAGE(bufoff, gbase, voff) do { _Pragma("unroll") for (int _i = 0; _i < 2; ++_i) \
        __builtin_amdgcn_global_load_lds((const unsigned*)((const char*)(gbase) + (voff)[_i]), (PG8_LAS unsigned*)(lds + (bufoff) + ldsw + _i * 8192), 16, 0, 0); } while (0)
#define PG8_LDA(dst, b, h) do { _Pragma("unroll") for (int m = 0; m < 4; ++m) _Pragma("unroll") for (int k = 0; k < 2; ++k) dst[m][k] = *(const PG8_LAS bf16x8*)(lds + PG8_SA(b, h) + aoff + m * 2048 + k * 1024); } while (0)
#define PG8_LDB(dst, b, h) do { _Pragma("unroll") for (int n = 0; n < 2; ++n) _Pragma("unroll") for (int k = 0; k < 2; ++k) dst[n][k] = *(const PG8_LAS bf16x8*)(lds + PG8_SB(b, h) + boff + n * 2048 + k * 1024); } while (0)
#define PG8_MMA(ai, bj, At, Bt) do { __builtin_amdgcn_s_setprio(1); _Pragma("unroll") for (int m = 0; m < 4; ++m) _Pragma("unroll") for (int n = 0; n < 2; ++n) _Pragma("unroll") for (int k = 0; k < 2; ++k) \
        acc[ai][bj][m][n] = TR ? __builtin_amdgcn_mfma_f32_16x16x32_bf16(At[m][k], Bt[n][k], acc[ai][bj][m][n], 0, 0, 0) : __builtin_amdgcn_mfma_f32_16x16x32_bf16(Bt[n][k], At[m][k], acc[ai][bj][m][n], 0, 0, 0); __builtin_amdgcn_s_setprio(0); } while (0)
#define PG8_WAIT_V(n) asm volatile("s_waitcnt vmcnt(" #n ")" ::: "memory")
#define PG8_WAIT_L(n) asm volatile("s_waitcnt lgkmcnt(" #n ")" ::: "memory")
#define PG8_BAR __builtin_amdgcn_s_barrier()
#define PG8_SCHED __builtin_amdgcn_sched_barrier(0)
    Unit cur, nxt; int ui = 0;
    if (!S.next(0, cur)) return;
    f32x4 acc[2][2][4][2];
#pragma unroll
    for (int a = 0; a < 2; ++a)
#pragma unroll
        for (int b = 0; b < 2; ++b)
#pragma unroll
            for (int m = 0; m < 4; ++m)
#pragma unroll
                for (int n = 0; n < 2; ++n) acc[a][b][m][n] = (f32x4){0.f, 0.f, 0.f, 0.f};
    bf16x8 At[4][2], B0[2][2], B1[2][2];
    const char* cA = (const char*)g.A + (size_t)cur.pm * tstep; const char* cB = (const char*)g.Bt + (size_t)cur.pn * tstep;
    S.a_ready(cur);
    if constexpr (SP2) {
        PG8_STAGE(PG8_SB(0, 0), cB, voffB); PG8_STAGE(PG8_SB(0, 1), cB + hstep, voffB); PG8_STAGE(PG8_SA(0, 0), cA, voffA); PG8_STAGE(PG8_SA(0, 1), cA + hstep, voffA);
        if (wr == 1) PG8_BAR;
        PG8_WAIT_V(2); PG8_BAR;
        PG8_STAGE(PG8_SB(1, 0), cB + kstep, voffB); PG8_STAGE(PG8_SA(1, 0), cA + kstep, voffA); PG8_STAGE(PG8_SB(1, 1), cB + hstep + kstep, voffB);
        PG8_WAIT_V(6); PG8_BAR;
    } else {
        PG8_STAGE(PG8_SB(0, 0), cB, voffB); PG8_STAGE(PG8_SA(0, 0), cA, voffA); PG8_STAGE(PG8_SB(0, 1), cB + hstep, voffB); PG8_STAGE(PG8_SA(0, 1), cA + hstep, voffA);
        if (wr == 1) PG8_BAR;
        PG8_WAIT_V(4); PG8_BAR;
        PG8_STAGE(PG8_SB(1, 0), cB + kstep, voffB); PG8_STAGE(PG8_SA(1, 0), cA + kstep, voffA); PG8_STAGE(PG8_SB(1, 1), cB + hstep + kstep, voffB);
        PG8_WAIT_V(6); PG8_BAR;
    }
    for (;;) {
        const bool has_next = S.next(ui + 1, nxt);
        const char* nA = has_next ? (const char*)g.A + (size_t)nxt.pm * tstep : cA; const char* nB = has_next ? (const char*)g.Bt + (size_t)nxt.pn * tstep : cB;
        for (int t = 0; t < nt; t += 2) {
            const bool last = (t == nt - 2);
            const char* a1 = cA + (size_t)(t + 1) * kstep;
            const char* a2 = last ? nA : cA + (size_t)(t + 2) * kstep; const char* b2 = last ? nB : cB + (size_t)(t + 2) * kstep;
            const char* a3 = a2 + kstep; const char* b3 = b2 + kstep;
            if (last && has_next) S.a_ready(nxt);
            if constexpr (SP2) {
            PG8_LDB(B0, 0, 0); PG8_LDB(B1, 0, 1); PG8_SCHED; PG8_LDA(At, 0, 0); PG8_STAGE(PG8_SA(1, 1), a1 + hstep, voffA);
            PG8_WAIT_V(8); PG8_WAIT_L(0); PG8_BAR; PG8_MMA(0, 0, At, B0); PG8_MMA(0, 1, At, B1); PG8_BAR; PG8_SCHED;
            PG8_LDA(At, 0, 1); PG8_STAGE(PG8_SB(0, 0), b2, voffB); PG8_STAGE(PG8_SB(0, 1), b2 + hstep, voffB); PG8_STAGE(PG8_SA(0, 0), a2, voffA);
            PG8_WAIT_V(8); PG8_WAIT_L(0); PG8_BAR; PG8_MMA(1, 0, At, B0); PG8_MMA(1, 1, At, B1); PG8_BAR; PG8_SCHED;
            PG8_LDB(B0, 1, 0); PG8_LDB(B1, 1, 1); PG8_SCHED; PG8_LDA(At, 1, 0); PG8_STAGE(PG8_SA(0, 1), a2 + hstep, voffA);
            PG8_WAIT_V(8); PG8_WAIT_L(0); PG8_BAR; PG8_MMA(0, 0, At, B0); PG8_MMA(0, 1, At, B1); PG8_BAR; PG8_SCHED;
            PG8_LDA(At, 1, 1); PG8_STAGE(PG8_SB(1, 0), b3, voffB); PG8_STAGE(PG8_SB(1, 1), b3 + hstep, voffB); PG8_STAGE(PG8_SA(1, 0), a3, voffA);
            PG8_WAIT_V(8); PG8_WAIT_L(0); PG8_BAR; PG8_MMA(1, 0, At, B0); PG8_MMA(1, 1, At, B1); PG8_BAR; PG8_SCHED;
            } else {
            PG8_LDB(B0, 0, 0); PG8_SCHED; PG8_LDA(At, 0, 0); PG8_STAGE(PG8_SA(1, 1), a1 + hstep, voffA);
            PG8_WAIT_L(8); PG8_BAR; PG8_WAIT_L(0); PG8_MMA(0, 0, At, B0); PG8_BAR; PG8_SCHED;
            PG8_LDB(B1, 0, 1); PG8_STAGE(PG8_SB(0, 0), b2, voffB);
            PG8_BAR; PG8_WAIT_L(0); PG8_MMA(0, 1, At, B1); PG8_BAR;
            PG8_LDA(At, 0, 1); PG8_STAGE(PG8_SA(0, 0), a2, voffA);
            PG8_BAR; PG8_WAIT_L(0); PG8_MMA(1, 0, At, B0); PG8_BAR; PG8_SCHED;
            PG8_STAGE(PG8_SB(0, 1), b2 + hstep, voffB);
            PG8_WAIT_V(6); PG8_BAR; PG8_MMA(1, 1, At, B1); PG8_BAR;
            PG8_LDB(B0, 1, 0); PG8_SCHED; PG8_LDA(At, 1, 0); PG8_STAGE(PG8_SA(0, 1), a2 + hstep, voffA);
            PG8_WAIT_L(8); PG8_BAR; PG8_WAIT_L(0); PG8_MMA(0, 0, At, B0); PG8_BAR; PG8_SCHED;
            PG8_LDB(B1, 1, 1); PG8_STAGE(PG8_SB(1, 0), b3, voffB);
            PG8_BAR; PG8_WAIT_L(0); PG8_MMA(0, 1, At, B1); PG8_BAR;
            PG8_LDA(At, 1, 1); PG8_STAGE(PG8_SA(1, 0), a3, voffA);
            PG8_BAR; PG8_WAIT_L(0); PG8_MMA(1, 0, At, B0); PG8_BAR; PG8_SCHED;
            PG8_STAGE(PG8_SB(1, 1), b3 + hstep, voffB);
            PG8_WAIT_V(6); PG8_BAR; PG8_MMA(1, 1, At, B1); PG8_BAR;
            }
        }
        if constexpr (ALIGN_EPI) { if (wr == 0) PG8_BAR; }
        if constexpr (!Epi::AFTER_DRAIN) { E(acc, cur, wr, wc, fr, fq); S.done(cur); }
        if (!has_next) break;
#pragma unroll
        for (int a = 0; a < 2; ++a)
#pragma unroll
            for (int b = 0; b < 2; ++b)
#pragma unroll
                for (int m = 0; m < 4; ++m)
#pragma unroll
                    for (int n = 0; n < 2; ++n) acc[a][b][m][n] = (f32x4){0.f, 0.f, 0.f, 0.f};
        cur = nxt; cA = nA; cB = nB; ++ui;
        if constexpr (ALIGN_EPI) { if (wr == 1) PG8_BAR; }
    }
    PG8_WAIT_V(0);
    if constexpr (!ALIGN_EPI) { if (wr == 0) PG8_BAR; }
    PG8_BAR;
    if constexpr (Epi::AFTER_DRAIN) { E.fused(acc, cur, wr, wc, fr, fq, lds, wid, lane); S.done(cur); }
#undef PG8_SA
#undef PG8_SB
#undef PG8_STAGE
#undef PG8_LDA
#undef PG8_LDB
#undef PG8_MMA
#undef PG8_WAIT_V
#undef PG8_WAIT_L
#undef PG8_BAR
#undef PG8_SCHED
}
}

#define GAS __attribute__((address_space(1)))
#define LAS __attribute__((address_space(3)))
typedef unsigned short bf16;
typedef short bf16x8 __attribute__((ext_vector_type(8)));
typedef float f32x4 __attribute__((ext_vector_type(4)));
typedef float f32x2 __attribute__((ext_vector_type(2)));
typedef unsigned u32x4 __attribute__((ext_vector_type(4)));
typedef unsigned u32x2 __attribute__((ext_vector_type(2)));

constexpr int NWAVES = 8, NTHR = 512;
constexpr int DM = 2048, NB = 16, SEQ = 2048, NTOK = NB * SEQ, CTXL = 256, NCTX = NB * CTXL, MROWS = NTOK + NCTX;
constexpr int LDK = 2048 + 64, LDF = 5632 + 64;
constexpr int INW = 6144, PW = pg8::PWP, DFF = 5632, NGU = 2 * DFF;
constexpr int PC_RQ = 1024, PC_RK = 1536, PC_RG = 2048;
constexpr float EPS = 1e-6f;

constexpr size_t MiB = 1u << 20;
constexpr size_t WS_M = 0;
constexpr size_t WS_M_BYTES = 17 * 12288 * 4;
constexpr size_t WS_ROPE = 1 * MiB;
constexpr size_t WS_BAR = 1 * MiB + 65536;
constexpr size_t WS_ZERO_BYTES = 1 * MiB + 131072;
constexpr int LDS_BARST_OFF = 147440;
constexpr size_t WS_WIN = 2 * MiB, WS_WOUT = 27 * MiB, WS_WGU = 36 * MiB, WS_WD = 82 * MiB;
constexpr size_t WS_H = 105 * MiB;
constexpr size_t WS_P = 255 * MiB;
constexpr size_t WS_KN = 476 * MiB, WS_KNC = 540 * MiB;
constexpr size_t WS_VT = 548 * MiB, WS_VTC = 676 * MiB;
constexpr size_t WS_HID = 255 * MiB;
constexpr size_t WS_Y = 896 * MiB;
constexpr size_t WS_MIX = 700 * MiB;
constexpr size_t WS_ST = 832 * MiB;
constexpr size_t WS_END = 1024 * MiB;
static_assert(WS_WIN + (size_t)INW * LDK * 2 <= WS_WOUT && WS_WOUT + (size_t)DM * LDK * 2 <= WS_WGU && WS_WGU + (size_t)NGU * LDK * 2 <= WS_WD && WS_WD + (size_t)DM * LDF * 2 <= WS_H && WS_H + (size_t)MROWS * LDK * 2 <= WS_P, "d_ws map (weights, H)");
static_assert(WS_P + (size_t)MROWS * PW * 2 <= WS_KN && WS_VTC + 16 * MiB <= WS_MIX && WS_HID + (size_t)NTOK * LDF * 2 <= WS_MIX && WS_MIX + (size_t)NTOK * LDK * 2 <= WS_ST, "d_ws map");
constexpr int LDS_BYTES = 147456;

__device__ __forceinline__ float bf2f(unsigned short s) { return __uint_as_float(((unsigned)s) << 16); }
__device__ __forceinline__ unsigned pk2(float lo, float hi) { return pg8::cvt_pk_bf16(lo, hi); }
__device__ __forceinline__ float wave_sum(float v) {
#pragma unroll
    for (int o = 1; o < 64; o <<= 1) v += __shfl_xor(v, o);
    return v;
}
#define MFMA16(a, b, c) __builtin_amdgcn_mfma_f32_16x16x32_bf16((a), (b), (c), 0, 0, 0)
#define LDS_WAIT() asm volatile("s_waitcnt lgkmcnt(0)" ::: "memory")

struct Args { const float* in[18]; float* out; unsigned char* ws; int pad0, pad1, pad2, pad3; };

__device__ __forceinline__ void p0_transpose_item(const float* W, int N, int k0, int n0, bf16* WT, int K, int drow0, LAS float* scr, int lane) {
    const int c4 = lane & 15, r = lane >> 4;
    const GAS f32x4* src = (const GAS f32x4*)(W + (size_t)(k0 + r) * N + n0) + c4;
    f32x4 v[16];
#pragma unroll
    for (int i = 0; i < 16; ++i) v[i] = src[(size_t)i * N];
#pragma unroll
    for (int i = 0; i < 16; ++i) { const int k = 4 * i + r; *(LAS f32x4*)(scr + k * 68 + ((4 * c4 + 8 * (k >> 3)) & 63)) = v[i]; }
    LDS_WAIT(); asm volatile("" ::: "memory");
    const int c = lane & 7, nh = lane >> 3;
#pragma unroll
    for (int jj = 0; jj < 8; ++jj) { const int n = nh + 8 * jj; const LAS float* s = scr + (8 * c) * 68 + ((n + 8 * c) & 63);
        u32x4 o; o.x = pk2(s[0 * 68], s[1 * 68]); o.y = pk2(s[2 * 68], s[3 * 68]); o.z = pk2(s[4 * 68], s[5 * 68]); o.w = pk2(s[6 * 68], s[7 * 68]);
        *(GAS u32x4*)(WT + (size_t)(drow0 + n) * K + k0 + 8 * c) = o; }
    LDS_WAIT(); asm volatile("" ::: "memory");
}

__device__ __forceinline__ void p0_prologue(const Args& a, LAS unsigned char* lds, int tid, int wave, int lane) {
    unsigned char* ws = a.ws;
    const int G = gridDim.x, bx = blockIdx.x;
    if (bx == G - 1 && tid < 16) {
        double w = 1.0; for (int i = 0; i < tid; ++i) w *= 0.5623413251903491;
        const double x2 = w * w; double tc = 1.0, ts = w, c1 = 1.0, s1 = w;
        for (int n = 1; n <= 12; ++n) { tc *= -x2 / (double)((2 * n - 1) * (2 * n)); c1 += tc; ts *= -x2 / (double)((2 * n) * (2 * n + 1)); s1 += ts; }
        double c = 1.0, s = 0.0; f32x2* tab = (f32x2*)(ws + WS_ROPE);
        for (int p = 0; p < 64; ++p) { tab[p * 16 + tid] = (f32x2){(float)c, (float)s}; const double cn = c * c1 - s * s1, sn = s * c1 + c * s1; c = cn; s = sn; }
    }
    if (bx < 192) {
        const int cb = bx % 48, ks = bx / 48;
        LAS float* sc = (LAS float*)lds;
        LAS float* red = (LAS float*)(lds + 36864);
        const float* cin = a.in[1]; const float* cctx = a.in[3];
        for (int idx = tid; idx < 17 * 512; idx += NTHR) { const int b = idx >> 9, k = idx & 511;
            const float cv = b < 16 ? cin[b * DM + 512 * ks + k] : cctx[512 * ks + k]; sc[idx] = cv / (1.0f + __expf(-cv)); }
        for (int idx = tid; idx < 17 * 256; idx += NTHR) red[idx] = 0.f;
        __syncthreads();
        f32x4 acc[17];
#pragma unroll
        for (int b = 0; b < 17; ++b) acc[b] = (f32x4){0.f, 0.f, 0.f, 0.f};
        const GAS f32x4* wp = (const GAS f32x4*)(a.in[4] + (size_t)(512 * ks + 64 * wave) * 12288 + 256 * cb) + lane;
#pragma unroll 8
        for (int kk = 0; kk < 64; ++kk) { const f32x4 w4 = wp[(size_t)kk * 3072];
#pragma unroll
            for (int b = 0; b < 17; ++b) { const float s = sc[b * 512 + 64 * wave + kk]; acc[b] += w4 * s; } }
#pragma unroll
        for (int b = 0; b < 17; ++b)
#pragma unroll
            for (int e = 0; e < 4; ++e) __hip_atomic_fetch_add(red + b * 256 + 4 * lane + e, acc[b][e], __ATOMIC_RELAXED, __HIP_MEMORY_SCOPE_WORKGROUP);
        __syncthreads();
        float* mv = (float*)(ws + WS_M); const float* ab = a.in[5];
        for (int idx = tid; idx < 17 * 256; idx += NTHR) { const int b = idx >> 8, col = idx & 255;
            float v = red[idx]; if (ks == 0) v += ab[256 * cb + col]; atomicAdd(mv + b * 12288 + 256 * cb + col, v); }
        __syncthreads();
    }
    LAS float* scr = (LAS float*)(lds + wave * 17408);
    const int gw = bx * NWAVES + wave, NGW = G * NWAVES;
    constexpr int I_IN = 32 * 96, I_OUT = 32 * 32, I_G = 32 * 88, I_D = 88 * 32, NITEMS = I_IN + I_OUT + 2 * I_G + I_D;
    for (int it = gw; it < NITEMS; it += NGW) {
        int r = it;
        if (r < I_IN) { const int kb = r / 96, nb = r % 96; p0_transpose_item(a.in[10], INW, 64 * kb, 64 * nb, (bf16*)(ws + WS_WIN), LDK, 64 * nb, scr, lane); continue; } r -= I_IN;
        if (r < I_OUT) { const int kb = r / 32, nb = r % 32; p0_transpose_item(a.in[14], DM, 64 * kb, 64 * nb, (bf16*)(ws + WS_WOUT), LDK, 64 * nb, scr, lane); continue; } r -= I_OUT;
        if (r < 2 * I_G) { const int up = r >= I_G; if (up) r -= I_G; const int kb = r / 88, nb = r % 88, n0 = 64 * nb;
            p0_transpose_item(a.in[up ? 16 : 15], DFF, 64 * kb, n0, (bf16*)(ws + WS_WGU), LDK, 256 * (n0 >> 7) + (n0 & 127) + (up ? 128 : 0), scr, lane); continue; } r -= 2 * I_G;
        { const int kb = r / 32, nb = r % 32; p0_transpose_item(a.in[17], DM, 64 * kb, 64 * nb, (bf16*)(ws + WS_WD), LDF, 64 * nb, scr, lane); }
    }
}

__device__ __forceinline__ void p1_modulate(const Args& a, int wave, int lane) {
    const int gw = blockIdx.x * NWAVES + wave, NGW = gridDim.x * NWAVES;
    const float* mv = (const float*)(a.ws + WS_M); bf16* H = (bf16*)(a.ws + WS_H);
    const GAS f32x4* gp = (const GAS f32x4*)a.in[6] + lane;
    for (int row = gw; row < MROWS; row += NGW) {
        const float* src = row < NTOK ? a.in[0] + (size_t)row * DM : a.in[2] + (size_t)(row - NTOK) * DM;
        const int vi = row < NTOK ? (row >> 11) : 16;
        const GAS f32x4* xr = (const GAS f32x4*)src + lane;
        const GAS f32x4* shp = (const GAS f32x4*)(mv + vi * 12288) + lane; const GAS f32x4* scp = (const GAS f32x4*)(mv + vi * 12288 + 2048) + lane;
        f32x4 v[8]; float ss = 0.f;
#pragma unroll
        for (int j = 0; j < 8; ++j) { v[j] = __builtin_nontemporal_load(xr + 64 * j); ss += (v[j].x * v[j].x + v[j].y * v[j].y) + (v[j].z * v[j].z + v[j].w * v[j].w); }
        const float rs = 1.0f / sqrtf(wave_sum(ss) * (1.0f / DM) + EPS);
        GAS u32x2* o = (GAS u32x2*)(H + (size_t)row * LDK) + lane;
#pragma unroll
        for (int j = 0; j < 8; ++j) { const f32x4 g = gp[64 * j], sh = shp[64 * j], sc = scp[64 * j];
            const f32x4 r = v[j] * rs * g * (sc + 1.0f) + sh; u32x2 w; w.x = pk2(r.x, r.y); w.y = pk2(r.z, r.w); o[64 * j] = w; }
    }
}

__device__ __forceinline__ void r1_block(const Args& a, LAS unsigned char* lds, int item, int tid, int wave, int lane) {
    const int b = item >> 4, h = (item >> 1) & 7, dir = item & 1, fr = lane & 15, fq = lane >> 4;
    const bf16* P = (const bf16*)(a.ws + WS_P); const bf16* Vt = (const bf16*)(a.ws + WS_VT); const bf16* Vtc = (const bf16*)(a.ws + WS_VTC); bf16* St = (bf16*)(a.ws + WS_ST);
    const float lg2 = a.in[dir ? 13 : 12][h] * 1.44269504089f;
    const float gC = __builtin_amdgcn_exp2f(128.0f * lg2);
    LAS bf16* Kt = (LAS bf16*)lds;
    f32x4 acc[4];
#pragma unroll
    for (int dt = 0; dt < 4; ++dt) acc[dt] = (f32x4){0.f, 0.f, 0.f, 0.f};
    const int j = tid >> 2, dp = tid & 3;
    const float dec = dir == 0 ? __builtin_amdgcn_exp2f((float)(127 - j) * lg2) : __builtin_amdgcn_exp2f((float)j * lg2);
#define R1_CC(s_) (dir == 0 ? ((s_) >= 2 ? (s_) - 2 : (s_)) : ((s_) >= 2 ? 17 - (s_) : 1 - (s_)))
#define R1_LOAD(s_, K0, K1, BV) do { const bool _lat = (s_) >= 2; const int _cc = R1_CC(s_); \
        const int _tok = _lat ? b * SEQ + 128 * _cc + j : NTOK + b * CTXL + 128 * _cc + j; \
        const GAS bf16x8* _kp = (const GAS bf16x8*)(P + (size_t)_tok * PW + PC_RK + h * 64 + 16 * dp); K0 = _kp[0]; K1 = _kp[1]; \
        const GAS char* _vb = (_lat ? (const GAS char*)Vt + ((size_t)(128 + b * 8 + h) * 256 + 16 * _cc + fq) * 2048 : (const GAS char*)Vtc + ((size_t)(128 + b * 8 + h) * 32 + 16 * _cc + fq) * 2048) + (16 * wave + fr) * 16; \
        _Pragma("unroll") for (int _ks = 0; _ks < 4; ++_ks) BV[_ks] = *(const GAS bf16x8*)(_vb + 8192 * _ks); } while (0)
    bf16x8 k0, k1, bv[4];
    R1_LOAD(0, k0, k1, bv);
#pragma unroll 1
    for (int s = 0; s < 18; ++s) {
        const bool lat = s >= 2; const int cc = R1_CC(s);
        if (lat) { bf16* sp = St + ((size_t)((((b * 8 + h) * 2 + dir) * 16 + cc) * 128 + 16 * wave + fr)) * 64 + 4 * fq;
#pragma unroll
            for (int dt = 0; dt < 4; ++dt) { u32x2 w; w.x = pk2(acc[dt][0], acc[dt][1]); w.y = pk2(acc[dt][2], acc[dt][3]); *(GAS u32x2*)(sp + 16 * dt) = w; } }
#pragma unroll
        for (int x = 0; x < 8; ++x) { Kt[(16 * dp + x) * 136 + j] = (bf16)(pk2(bf2f((unsigned short)k0[x]) * dec, 0.f) & 0xffffu); Kt[(16 * dp + 8 + x) * 136 + j] = (bf16)(pk2(bf2f((unsigned short)k1[x]) * dec, 0.f) & 0xffffu); }
        __syncthreads();
        bf16x8 bc[4];
#pragma unroll
        for (int ks = 0; ks < 4; ++ks) bc[ks] = bv[ks];
        if (s + 1 < 18) R1_LOAD(s + 1, k0, k1, bv);
#pragma unroll
        for (int dt = 0; dt < 4; ++dt) acc[dt] *= gC;
#pragma unroll
        for (int ks = 0; ks < 4; ++ks) {
#pragma unroll
            for (int dt = 0; dt < 4; ++dt) { const bf16x8 av = *(const LAS bf16x8*)(Kt + (16 * dt + fr) * 136 + 32 * ks + 8 * fq); acc[dt] = MFMA16(av, bc[ks], acc[dt]); } }
        __syncthreads();
    }
#undef R1_CC
#undef R1_LOAD
}

#define NA_LD8(dst, ub, vo, s0, s1) do { _Pragma("unroll") for (int _i = 0; _i < 8; ++_i) dst[_i] = *(const GAS bf16x8*)((ub) + (size_t)((_i >> 2) * (s0) + (_i & 3) * (s1)) + (vo)); } while (0)
#define NA_LDV8(dst, ub, vo, s0) do { _Pragma("unroll") for (int _i = 0; _i < 8; ++_i) dst[_i] = *(const GAS bf16x8*)((ub) + (size_t)(_i * (s0)) + (vo)); } while (0)
#define NA_LD8_L(dst, lb, vo, s0, s1) do { _Pragma("unroll") for (int _i = 0; _i < 8; ++_i) dst[_i] = *(const LAS bf16x8*)((lb) + ((_i >> 2) * (s0) + (_i & 3) * (s1)) + (vo)); } while (0)
#define NA_LDV8_L(dst, lb, vo, s0) do { _Pragma("unroll") for (int _i = 0; _i < 8; ++_i) dst[_i] = *(const LAS bf16x8*)((lb) + (_i * (s0)) + (vo)); } while (0)
#define NA_QK(d0, d1, src) do { f32x4 _a = (f32x4){0.f, 0.f, 0.f, 0.f}, _b = _a; _Pragma("unroll") for (int _k = 0; _k < 4; ++_k) { _a = MFMA16(src[_k], qf[_k], _a); _b = MFMA16(src[4 + _k], qf[_k], _b); } d0 = _a; d1 = _b; } while (0)
#define NA_PACK(pf, s0, s1) do { u32x4 _pw; _pw.x = pk2(s0[0], s0[1]); _pw.y = pk2(s0[2], s0[3]); _pw.z = pk2(s1[0], s1[1]); _pw.w = pk2(s1[2], s1[3]); pf = __builtin_bit_cast(bf16x8, _pw); } while (0)
#define NA_PV(src, pf) do { _Pragma("unroll") for (int _v = 0; _v < 8; ++_v) o[_v] = MFMA16(src[_v], pf, o[_v]); } while (0)
constexpr int NA_KC_OFF = 0, NA_KC_PITCH = 272, NA_VC_OFF = 256 * 272, NA_VC_PITCH = 528, NA_RPB_OFF = NA_VC_OFF + 128 * 528;
template <bool LOCAL> __device__ __forceinline__ void na_step(f32x4& s0, f32x4& s1, bool tv, unsigned cmask, const LAS float* brow, float& m, float& l, f32x4 (&o)[8], bf16x8& pf) {
    const float SC = 0.08838834764831845f * 1.44269504089f, L2E = 1.44269504089f, NEG = -1e30f;
    float v[8]; float mx = NEG;
#pragma unroll
    for (int x = 0; x < 8; ++x) { const float raw = x < 4 ? s0[x] : s1[x - 4];
        if (LOCAL) { float bias = brow[x]; asm volatile("" : "+v"(bias)); const bool ok = tv && ((cmask >> x) & 1u); v[x] = ok ? raw * SC + bias * L2E : NEG; }
        else v[x] = raw * SC;
        mx = fmaxf(mx, v[x]); }
    mx = fmaxf(mx, __shfl_xor(mx, 16)); mx = fmaxf(mx, __shfl_xor(mx, 32));
    const float mn = fmaxf(m, mx), sc = __builtin_amdgcn_exp2f(m - mn);
    float ps = 0.f;
#pragma unroll
    for (int x = 0; x < 8; ++x) { float p = __builtin_amdgcn_exp2f(v[x] - mn); if (LOCAL) p = v[x] > -1e29f ? p : 0.f; v[x] = p; ps += p; }
    l = l * sc + ps; m = mn;
#pragma unroll
    for (int vt = 0; vt < 8; ++vt) o[vt] = o[vt] * sc;
    u32x4 pw; pw.x = pk2(v[0], v[1]); pw.y = pk2(v[2], v[3]); pw.z = pk2(v[4], v[5]); pw.w = pk2(v[6], v[7]); pf = __builtin_bit_cast(bf16x8, pw);
}
__device__ __forceinline__ void na_wave(const Args& a, const LAS unsigned char* lds, int b, int h, int r0, int ct, int lane) {
    const LAS float* rpb = (const LAS float*)(lds + NA_RPB_OFF);
    const LAS unsigned char* kcl = lds + NA_KC_OFF; const LAS unsigned char* vcl = lds + NA_VC_OFF;
    const int fr = lane & 15, fq = lane >> 4;
    const bf16* P = (const bf16*)(a.ws + WS_P); const bf16* Vt = (const bf16*)(a.ws + WS_VT); const bf16* Kn = (const bf16*)(a.ws + WS_KN); bf16* MIX = (bf16*)(a.ws + WS_MIX);
    const int c0 = 16 * ct, kc0 = min(max(c0 - 8, 0), 32), rs0 = min(max(r0 - 4, 0), 24), rs1 = min(max(r0 - 3, 0), 24), d = rs1 - rs0;
    const int qtok = b * SEQ + r0 * 64 + c0 + fr;
    bf16x8 qf[2][4];
    { const GAS char* qu = (const GAS char*)P + ((size_t)(b * SEQ + r0 * 64 + c0) * PW + h * 128) * 2; const unsigned qo = (unsigned)(fr * PW + 8 * fq) * 2u;
#pragma unroll
      for (int ks = 0; ks < 4; ++ks) { qf[0][ks] = *(const GAS bf16x8*)(qu + 64 * ks + qo); qf[1][ks] = *(const GAS bf16x8*)(qu + (size_t)64 * PW * 2 + 64 * ks + qo); } }
    const int koff = 8 * (fr >> 2) + (fr & 3);
    const int c = c0 + fr, cs = min(max(c - 8, 0), 48);
    unsigned cmask = 0u;
#pragma unroll
    for (int x = 0; x < 8; ++x) { const int kc = kc0 + 8 * fq + x; if (kc >= cs && kc < cs + 16) cmask |= 1u << x; }
    const int dcb = kc0 + 8 * fq - c + 15;
    const GAS char* kl = (const GAS char*)Kn + ((size_t)(b * 8 + h) * 256 + (rs0 * 64 + kc0) / 8) * 2048;
    const GAS char* vl = (const GAS char*)Vt + ((size_t)(b * 8 + h) * 256 + (rs0 * 64 + kc0) / 8) * 2048;
    const unsigned klo = (unsigned)((fr >> 2) * 2048 + (fr & 3) * 64 + fq * 16), vlo = (unsigned)(fq * 2048 + fr * 16);
    const int kcl_lo = koff * NA_KC_PITCH + 16 * fq, vcl_lo = fr * NA_VC_PITCH + 16 * fq;
    f32x4 o0[8], o1[8];
#pragma unroll
    for (int vt = 0; vt < 8; ++vt) { o0[vt] = (f32x4){0.f, 0.f, 0.f, 0.f}; o1[vt] = o0[vt]; }
    float m0 = -1e30f, m1 = -1e30f, l0 = 0.f, l1 = 0.f;
    bf16x8 fa[8], fb[8];
    const int nkr = 8 + d;
    NA_LDV8(fb, vl, vlo, 256);
#pragma unroll 1
    for (int kr = 0; kr < nkr; ++kr) {
        NA_LD8(fa, kl + (size_t)kr * 16384, klo, 256, 512);
        f32x4 sa0, sa1, sb0, sb1;
        { f32x4 z = (f32x4){0.f, 0.f, 0.f, 0.f}; sa0 = z; sa1 = z; sb0 = z; sb1 = z; }
#pragma unroll
        for (int ks = 0; ks < 4; ++ks) { sa0 = MFMA16(fa[ks], qf[0][ks], sa0); sa1 = MFMA16(fa[4 + ks], qf[0][ks], sa1); sb0 = MFMA16(fa[ks], qf[1][ks], sb0); sb1 = MFMA16(fa[4 + ks], qf[1][ks], sb1); }
        bf16x8 pf0, pf1;
        { const int dr0 = rs0 + kr - r0, dr1 = dr0 - 1;
          na_step<true>(sa0, sa1, kr <= 7, cmask, rpb + min(max(dr0 + 7, 0), 14) * 31 + dcb, m0, l0, o0, pf0);
          na_step<true>(sb0, sb1, kr >= d, cmask, rpb + min(max(dr1 + 7, 0), 14) * 31 + dcb, m1, l1, o1, pf1); }
#pragma unroll
        for (int vt = 0; vt < 8; ++vt) { o0[vt] = MFMA16(fb[vt], pf0, o0[vt]); o1[vt] = MFMA16(fb[vt], pf1, o1[vt]); }
        if (kr + 1 < nkr) NA_LDV8(fb, vl + (size_t)(kr + 1) * 16384, vlo, 256);
    }
#pragma unroll 1
    for (int g = 0; g < 8; ++g) {
        NA_LD8_L(fa, kcl + g * 32 * NA_KC_PITCH, kcl_lo, 4 * NA_KC_PITCH, 64);
        f32x4 sa0, sa1, sb0, sb1;
        { f32x4 z = (f32x4){0.f, 0.f, 0.f, 0.f}; sa0 = z; sa1 = z; sb0 = z; sb1 = z; }
#pragma unroll
        for (int ks = 0; ks < 4; ++ks) { sa0 = MFMA16(fa[ks], qf[0][ks], sa0); sa1 = MFMA16(fa[4 + ks], qf[0][ks], sa1); sb0 = MFMA16(fa[ks], qf[1][ks], sb0); sb1 = MFMA16(fa[4 + ks], qf[1][ks], sb1); }
        NA_LDV8_L(fb, vcl + g * 64, vcl_lo, 16 * NA_VC_PITCH);
        bf16x8 pf0, pf1;
        na_step<false>(sa0, sa1, true, 0xffu, rpb, m0, l0, o0, pf0);
        na_step<false>(sb0, sb1, true, 0xffu, rpb, m1, l1, o1, pf1);
#pragma unroll
        for (int vt = 0; vt < 8; ++vt) { o0[vt] = MFMA16(fb[vt], pf0, o0[vt]); o1[vt] = MFMA16(fb[vt], pf1, o1[vt]); }
    }
    l0 += __shfl_xor(l0, 16); l0 += __shfl_xor(l0, 32); l1 += __shfl_xor(l1, 16); l1 += __shfl_xor(l1, 32);
    const float i0 = 1.0f / l0, i1 = 1.0f / l1;
    bf16* op = MIX + (size_t)qtok * LDK + h * 128 + 4 * fq;
#pragma unroll
    for (int vt = 0; vt < 8; ++vt) { u32x2 w; w.x = pk2(o0[vt][0] * i0, o0[vt][1] * i0); w.y = pk2(o0[vt][2] * i0, o0[vt][3] * i0); *(GAS u32x2*)(op + 16 * vt) = w;
        u32x2 w2; w2.x = pk2(o1[vt][0] * i1, o1[vt][1] * i1); w2.y = pk2(o1[vt][2] * i1, o1[vt][3] * i1); *(GAS u32x2*)(op + (size_t)64 * LDK + 16 * vt) = w2; }
}

constexpr int R2_K_OFF = 0, R2_K_PITCH = 144, R2_V_OFF = 128 * 144, R2_V_PITCH = 272, R2_SF_OFF = R2_V_OFF + 128 * 272, R2_SB_OFF = R2_SF_OFF + 128 * 144, R2_S_PITCH = 144, R2_LDS_END = R2_SB_OFF + 128 * 144;
struct R2Regs { bf16x8 kv[2], vv[4], sfv[2], sbv[2]; };
__device__ __forceinline__ void r2_load(const Args& a, R2Regs& r, int b, int h, int c, int tid) {
    const bf16* P = (const bf16*)(a.ws + WS_P); const bf16* Vt = (const bf16*)(a.ws + WS_VT); const bf16* St = (const bf16*)(a.ws + WS_ST);
#pragma unroll
    for (int j = 0; j < 2; ++j) { const int idx = tid + NTHR * j, row = idx >> 3, ch = idx & 7;
        r.kv[j] = *(const GAS bf16x8*)(P + (size_t)(b * SEQ + 128 * c + row) * PW + PC_RK + h * 64 + 8 * ch);
        r.sfv[j] = *(const GAS bf16x8*)(St + ((size_t)((((b * 8 + h) * 2 + 0) * 16 + c) * 128 + row)) * 64 + 8 * ch);
        r.sbv[j] = *(const GAS bf16x8*)(St + ((size_t)((((b * 8 + h) * 2 + 1) * 16 + c) * 128 + row)) * 64 + 8 * ch); }
#pragma unroll
    for (int j = 0; j < 4; ++j) { const int idx = tid + NTHR * j;
        r.vv[j] = *(const GAS bf16x8*)((const GAS char*)Vt + ((size_t)(128 + b * 8 + h) * 256 + 16 * c) * 2048 + (size_t)idx * 16); }
}
__device__ __forceinline__ void r2_store(const R2Regs& r, LAS unsigned char* lds, int tid) {
#pragma unroll
    for (int j = 0; j < 2; ++j) { const int idx = tid + NTHR * j, row = idx >> 3, ch = idx & 7;
        *(LAS bf16x8*)(lds + R2_K_OFF + row * R2_K_PITCH + 16 * ch) = r.kv[j]; *(LAS bf16x8*)(lds + R2_SF_OFF + row * R2_S_PITCH + 16 * ch) = r.sfv[j]; *(LAS bf16x8*)(lds + R2_SB_OFF + row * R2_S_PITCH + 16 * ch) = r.sbv[j]; }
#pragma unroll
    for (int j = 0; j < 4; ++j) { const int idx = tid + NTHR * j, gr = idx >> 7, vd = idx & 127; *(LAS bf16x8*)(lds + R2_V_OFF + vd * R2_V_PITCH + 16 * gr) = r.vv[j]; }
}
__device__ __forceinline__ void r2_wave(const Args& a, const LAS unsigned char* lds, int b, int h, int c, int it, int lane) {
    const int fr = lane & 15, fq = lane >> 4;
    const bf16* P = (const bf16*)(a.ws + WS_P); const bf16* Vt = (const bf16*)(a.ws + WS_VT); const bf16* St = (const bf16*)(a.ws + WS_ST); bf16* MIX = (bf16*)(a.ws + WS_MIX);
    const float lgf = a.in[12][h] * 1.44269504089f, lgb = a.in[13][h] * 1.44269504089f;
    const int i = 16 * it + fr, tokq = b * SEQ + 128 * c + i;
    bf16x8 qf[2];
    { const GAS char* qu = (const GAS char*)P + ((size_t)(b * SEQ + 128 * c + 16 * it) * PW + PC_RQ + h * 64) * 2; const unsigned qo = (unsigned)(fr * PW + 8 * fq) * 2u;
      qf[0] = *(const GAS bf16x8*)(qu + qo); qf[1] = *(const GAS bf16x8*)(qu + 64 + qo); }
    const int koff = 8 * (fr >> 2) + (fr & 3);
    const LAS unsigned char* kb = lds + R2_K_OFF;
    const LAS unsigned char* vb = lds + R2_V_OFF;
    const LAS unsigned char* sf = lds + R2_SF_OFF;
    const LAS unsigned char* sb = lds + R2_SB_OFF;
    const int klo = koff * R2_K_PITCH + 16 * fq, vlo = fr * R2_V_PITCH + 16 * fq, slo = fr * R2_S_PITCH + 16 * fq;
    bf16x8 fa[8], fb[8];
#define R2_SB() __builtin_amdgcn_sched_barrier(0)
#pragma unroll
    for (int x = 0; x < 8; ++x) fa[x] = *(const LAS bf16x8*)(kb + (32 * (x >> 2) + 4 * ((x >> 1) & 1)) * R2_K_PITCH + 64 * (x & 1) + klo);
#pragma unroll
    for (int x = 0; x < 8; ++x) fb[x] = *(const LAS bf16x8*)(kb + (64 + 32 * (x >> 2) + 4 * ((x >> 1) & 1)) * R2_K_PITCH + 64 * (x & 1) + klo);
    R2_SB();
    f32x4 s[8];
#pragma unroll
    for (int x = 0; x < 4; ++x) { f32x4 v = (f32x4){0.f, 0.f, 0.f, 0.f}; v = MFMA16(fa[2 * x], qf[0], v); v = MFMA16(fa[2 * x + 1], qf[1], v); s[x] = v; }
    R2_SB();
    NA_LDV8_L(fa, vb, vlo, 16 * R2_V_PITCH);
#pragma unroll
    for (int x = 0; x < 4; ++x) { f32x4 v = (f32x4){0.f, 0.f, 0.f, 0.f}; v = MFMA16(fb[2 * x], qf[0], v); v = MFMA16(fb[2 * x + 1], qf[1], v); s[4 + x] = v; }
    R2_SB();
    NA_LDV8_L(fb, vb + 64, vlo, 16 * R2_V_PITCH);
#pragma unroll
    for (int x = 0; x < 8; ++x)
#pragma unroll
        for (int e = 0; e < 4; ++e) { const int jj = 32 * (x >> 1) + 8 * fq + 4 * (x & 1) + e; const int d = i - jj;
            const float df = d >= 0 ? __builtin_amdgcn_exp2f((float)d * lgf) : 0.f, db = d <= 0 ? __builtin_amdgcn_exp2f((float)(-d) * lgb) : 0.f;
            s[x][e] *= (df + db); }
    R2_SB();
    f32x4 o[8], ox[8];
#pragma unroll
    for (int vt = 0; vt < 8; ++vt) o[vt] = (f32x4){0.f, 0.f, 0.f, 0.f};
    { bf16x8 pf;
      NA_PACK(pf, s[0], s[1]); NA_PV(fa, pf); R2_SB();
      NA_LDV8_L(fa, vb + 128, vlo, 16 * R2_V_PITCH);
      NA_PACK(pf, s[2], s[3]); NA_PV(fb, pf); R2_SB();
      NA_LDV8_L(fb, vb + 192, vlo, 16 * R2_V_PITCH);
      NA_PACK(pf, s[4], s[5]); NA_PV(fa, pf); R2_SB();
      NA_LDV8_L(fa, sf, slo, 16 * R2_S_PITCH);
      NA_PACK(pf, s[6], s[7]); NA_PV(fb, pf); R2_SB(); }
    const float wf = __builtin_amdgcn_exp2f((float)(i + 1) * lgf), wb = __builtin_amdgcn_exp2f((float)(128 - i) * lgb);
    NA_LDV8_L(fb, sf + 64, slo, 16 * R2_S_PITCH);
#pragma unroll
    for (int vt = 0; vt < 8; ++vt) ox[vt] = MFMA16(fa[vt], qf[0], ((f32x4){0.f, 0.f, 0.f, 0.f}));
    R2_SB();
    NA_LDV8_L(fa, sb, slo, 16 * R2_S_PITCH);
#pragma unroll
    for (int vt = 0; vt < 8; ++vt) ox[vt] = MFMA16(fb[vt], qf[1], ox[vt]);
    R2_SB();
    NA_LDV8_L(fb, sb + 64, slo, 16 * R2_S_PITCH);
#pragma unroll
    for (int vt = 0; vt < 8; ++vt) { o[vt] = o[vt] + ox[vt] * wf; ox[vt] = MFMA16(fa[vt], qf[0], ((f32x4){0.f, 0.f, 0.f, 0.f})); }
    R2_SB();
#pragma unroll
    for (int vt = 0; vt < 8; ++vt) ox[vt] = MFMA16(fb[vt], qf[1], ox[vt]);
#pragma unroll
    for (int vt = 0; vt < 8; ++vt) o[vt] = o[vt] + ox[vt] * wb;
    R2_SB();
#undef R2_SB
    float sum = 0.f;
#pragma unroll
    for (int vt = 0; vt < 8; ++vt) { sum += (o[vt][0] + o[vt][1]) + (o[vt][2] + o[vt][3]); }
    sum += __shfl_xor(sum, 16); sum += __shfl_xor(sum, 32);
    const float mu = sum * (1.0f / 128.0f); float q = 0.f;
#pragma unroll
    for (int vt = 0; vt < 8; ++vt) { o[vt] = o[vt] - mu; q += (o[vt][0] * o[vt][0] + o[vt][1] * o[vt][1]) + (o[vt][2] * o[vt][2] + o[vt][3] * o[vt][3]); }
    q += __shfl_xor(q, 16); q += __shfl_xor(q, 32);
    const float rstd = 1.0f / sqrtf(q * (1.0f / 128.0f) + EPS);
    const GAS u32x2* gp = (const GAS u32x2*)(P + (size_t)tokq * PW + PC_RG + h * 128 + 4 * fq);
    bf16* op = MIX + (size_t)tokq * LDK + 1024 + h * 128 + 4 * fq;
    u32x2 gw[8];
#pragma unroll
    for (int vt = 0; vt < 8; ++vt) gw[vt] = gp[4 * vt];
#pragma unroll
    for (int vt = 0; vt < 8; ++vt) {
        const float g0 = __uint_as_float(gw[vt].x << 16), g1 = __uint_as_float(gw[vt].x & 0xffff0000u), g2 = __uint_as_float(gw[vt].y << 16), g3 = __uint_as_float(gw[vt].y & 0xffff0000u);
        u32x2 w; w.x = pk2(o[vt][0] * rstd * pg8::silu_f(g0), o[vt][1] * rstd * pg8::silu_f(g1)); w.y = pk2(o[vt][2] * rstd * pg8::silu_f(g2), o[vt][3] * rstd * pg8::silu_f(g3));
        *(GAS u32x2*)(op + 16 * vt) = w; }
}

__device__ __forceinline__ void p6_rows(const Args& a, int wave, int lane) {
    const int gw = blockIdx.x * NWAVES + wave, NGW = gridDim.x * NWAVES;
    const float* mv = (const float*)(a.ws + WS_M); const bf16* Y = (const bf16*)(a.ws + WS_Y); bf16* H = (bf16*)(a.ws + WS_H);
    const GAS f32x4* wpost = (const GAS f32x4*)a.in[7] + lane; const GAS f32x4* wpre = (const GAS f32x4*)a.in[8] + lane;
    for (int row = gw; row < NTOK; row += NGW) {
        const float* mrow = mv + (row >> 11) * 12288;
        const GAS f32x4* g1p = (const GAS f32x4*)(mrow + 4096) + lane; const GAS f32x4* sh2p = (const GAS f32x4*)(mrow + 6144) + lane; const GAS f32x4* sc2p = (const GAS f32x4*)(mrow + 8192) + lane;
        const GAS u32x2* yp = (const GAS u32x2*)(Y + (size_t)row * DM) + lane; const GAS f32x4* xp = (const GAS f32x4*)(a.in[0] + (size_t)row * DM) + lane;
        f32x4 y[8], x[8]; float ss = 0.f;
#pragma unroll
        for (int j = 0; j < 8; ++j) { const u32x2 w = yp[64 * j]; x[j] = __builtin_nontemporal_load(xp + 64 * j);
            y[j] = (f32x4){__uint_as_float(w.x << 16), __uint_as_float(w.x & 0xffff0000u), __uint_as_float(w.y << 16), __uint_as_float(w.y & 0xffff0000u)};
            ss += (y[j].x * y[j].x + y[j].y * y[j].y) + (y[j].z * y[j].z + y[j].w * y[j].w); }
        const float rs = 1.0f / sqrtf(wave_sum(ss) * (1.0f / DM) + EPS);
        float s2 = 0.f;
#pragma unroll
        for (int j = 0; j < 8; ++j) { x[j] = x[j] + g1p[64 * j] * (y[j] * rs * wpost[64 * j]);
            s2 += (x[j].x * x[j].x + x[j].y * x[j].y) + (x[j].z * x[j].z + x[j].w * x[j].w); }
        const float rs2 = 1.0f / sqrtf(wave_sum(s2) * (1.0f / DM) + EPS);
        GAS u32x2* hp = (GAS u32x2*)(H + (size_t)row * LDK) + lane;
#pragma unroll
        for (int j = 0; j < 8; ++j) { const f32x4 r = x[j] * rs2 * wpre[64 * j] * (sc2p[64 * j] + 1.0f) + sh2p[64 * j]; u32x2 w; w.x = pk2(r.x, r.y); w.y = pk2(r.z, r.w); hp[64 * j] = w; }
    }
}
__device__ __forceinline__ void p9_rows(const Args& a, int wave, int lane) {
    const int gw = blockIdx.x * NWAVES + wave, NGW = gridDim.x * NWAVES;
    const float* mv = (const float*)(a.ws + WS_M); const bf16* F = (const bf16*)(a.ws + WS_MIX); const bf16* Y = (const bf16*)(a.ws + WS_Y);
    const GAS f32x4* wpost = (const GAS f32x4*)a.in[9] + lane; const GAS f32x4* wpm = (const GAS f32x4*)a.in[7] + lane;
    for (int row = gw; row < NTOK; row += NGW) {
        const GAS f32x4* g1p = (const GAS f32x4*)(mv + (row >> 11) * 12288 + 4096) + lane; const GAS f32x4* g2p = (const GAS f32x4*)(mv + (row >> 11) * 12288 + 10240) + lane;
        const GAS u32x2* fp = (const GAS u32x2*)(F + (size_t)row * DM) + lane; const GAS u32x2* yp = (const GAS u32x2*)(Y + (size_t)row * DM) + lane;
        const GAS f32x4* xp = (const GAS f32x4*)(a.in[0] + (size_t)row * DM) + lane; GAS f32x4* op = (GAS f32x4*)(a.out + (size_t)row * DM) + lane;
        f32x4 x[8]; u32x2 fw[8], yw[8]; float ssy = 0.f, ssf = 0.f;
#pragma unroll
        for (int j = 0; j < 8; ++j) { x[j] = __builtin_nontemporal_load(xp + 64 * j); fw[j] = __builtin_nontemporal_load(fp + 64 * j); yw[j] = __builtin_nontemporal_load(yp + 64 * j); }
#pragma unroll
        for (int j = 0; j < 8; ++j) {
            const f32x4 y = (f32x4){__uint_as_float(yw[j].x << 16), __uint_as_float(yw[j].x & 0xffff0000u), __uint_as_float(yw[j].y << 16), __uint_as_float(yw[j].y & 0xffff0000u)};
            const f32x4 f = (f32x4){__uint_as_float(fw[j].x << 16), __uint_as_float(fw[j].x & 0xffff0000u), __uint_as_float(fw[j].y << 16), __uint_as_float(fw[j].y & 0xffff0000u)};
            ssy += (y.x * y.x + y.y * y.y) + (y.z * y.z + y.w * y.w); ssf += (f.x * f.x + f.y * f.y) + (f.z * f.z + f.w * f.w); }
        const float rsy = 1.0f / sqrtf(wave_sum(ssy) * (1.0f / DM) + EPS), rsf = 1.0f / sqrtf(wave_sum(ssf) * (1.0f / DM) + EPS);
#pragma unroll
        for (int j = 0; j < 8; ++j) {
            const f32x4 y = (f32x4){__uint_as_float(yw[j].x << 16), __uint_as_float(yw[j].x & 0xffff0000u), __uint_as_float(yw[j].y << 16), __uint_as_float(yw[j].y & 0xffff0000u)};
            const f32x4 f = (f32x4){__uint_as_float(fw[j].x << 16), __uint_as_float(fw[j].x & 0xffff0000u), __uint_as_float(fw[j].y << 16), __uint_as_float(fw[j].y & 0xffff0000u)};
            __builtin_nontemporal_store((x[j] + g1p[64 * j] * (y * rsy * wpm[64 * j])) + g2p[64 * j] * (f * rsf * wpost[64 * j]), op + 64 * j); }
    }
}

#define RLX_AGENT __ATOMIC_RELAXED, __HIP_MEMORY_SCOPE_AGENT
#define XB_TMO      128
#define XB_XCNT(j)  (256  + 64 * (j))
#define XB_XSUB(j)  (1280 + 64 * (j))
#define XB_XGEN(j)  (2304 + 64 * (j))
#define XB_TOP      3328
#define XB_TOPGEN   3392
#define XCD_BAR_WORDS 3456
#define XB_SPIN_CAP (1u << 18)

__device__ __forceinline__ unsigned xb_ld(unsigned* p)              { return __hip_atomic_load(p, __ATOMIC_RELAXED, __HIP_MEMORY_SCOPE_AGENT); }
__device__ __forceinline__ unsigned xb_add(unsigned* p, unsigned v) { return __hip_atomic_fetch_add(p, v, __ATOMIC_RELAXED, __HIP_MEMORY_SCOPE_AGENT); }
__device__ __forceinline__ unsigned xb_xcc_id() { return (unsigned)__builtin_amdgcn_s_getreg((3 << 11) | 20) & 0xFu; }
#define XB_SPIN(cond, bar) do { unsigned _sp = 0; while (cond) { __builtin_amdgcn_s_sleep(1); \
    if ((++_sp & 255u) == 0u) { if (xb_ld(&(bar)[XB_TMO])) break; if (_sp > XB_SPIN_CAP) { atomicAdd(&(bar)[XB_TMO], 1u); break; } } } } while (0)

struct XcdBarrier {
    unsigned* bar; unsigned x;
    volatile LAS unsigned* st;
};

__device__ __forceinline__ XcdBarrier xcd_barrier_post(unsigned* bar, volatile LAS unsigned* st) {
    XcdBarrier b; b.bar = bar; b.x = xb_xcc_id(); b.st = st;
    if (threadIdx.x == 0) (void)xb_add(&bar[XB_XCNT(b.x)], 1u);
    return b;
}
__device__ __forceinline__ void xcd_barrier_complete(unsigned* bar, unsigned x, unsigned& nloc, unsigned& nx) {
    const unsigned G = gridDim.x * gridDim.y * gridDim.z;
    unsigned sum, cnt, mine, sp = 0u;
    for (;;) {
        sum = 0u; cnt = 0u; mine = 0u;
#pragma unroll
        for (unsigned j = 0; j < 16; ++j) { const unsigned c = xb_ld(&bar[XB_XCNT(j)]); sum += c; cnt += (c > 0u) ? 1u : 0u; mine = (j == x) ? c : mine; }
        if (sum == G) break;
        __builtin_amdgcn_s_sleep(1);
        if ((++sp & 255u) == 0u) { if (xb_ld(&bar[XB_TMO])) break; if (sp > XB_SPIN_CAP) { atomicAdd(&bar[XB_TMO], 1u); break; } }
    }
    nloc = mine > 0u ? mine : 1u; nx = cnt > 0u ? cnt : 1u;
}

__device__ __forceinline__ void xcd_barrier(const XcdBarrier& b) {
    asm volatile("s_waitcnt vmcnt(0)" ::: "memory");
    __syncthreads();
    if (threadIdx.x == 0) {
        unsigned* bar = b.bar;
        __builtin_amdgcn_s_waitcnt(0);
        unsigned nloc = b.st[0], nx = b.st[1];
        if (nloc == 0u) { xcd_barrier_complete(bar, b.x, nloc, nx); b.st[0] = nloc; b.st[1] = nx; }
        const unsigned old = xb_add(&bar[XB_XSUB(b.x)], 1u);
        const unsigned gen = old / nloc;
        if (old + 1u == (gen + 1u) * nloc) {
            __builtin_amdgcn_fence(__ATOMIC_RELEASE, "agent");
            asm volatile("s_waitcnt vmcnt(0)" ::: "memory");
            const unsigned og = xb_add(&bar[XB_TOP], 1u);
            const unsigned tg = og / nx;
            if (og + 1u == (tg + 1u) * nx) xb_add(&bar[XB_TOPGEN], 1u);
            else XB_SPIN(xb_ld(&bar[XB_TOPGEN]) == tg, bar);
            __builtin_amdgcn_fence(__ATOMIC_ACQUIRE, "agent");
            xb_add(&bar[XB_XGEN(b.x)], 1u);
            asm volatile("s_waitcnt vmcnt(0)" ::: "memory");
        } else {
            XB_SPIN(xb_ld(&bar[XB_XGEN(b.x)]) == gen, bar);
            __builtin_amdgcn_fence(__ATOMIC_ACQUIRE, "agent");
            asm volatile("s_waitcnt vmcnt(0)" ::: "memory");
        }
    }
    __syncthreads();
}

#ifndef MK_REP_MASK
#define MK_REP_MASK 0
#endif
template <int PH> __device__ __forceinline__ void run_phase(const Args& a, LAS unsigned char* lds, int tid_in, int wave_in, int lane_in) {
    typedef pg8::bf16_t pb;
    int tid = threadIdx.x; asm volatile("" : "+v"(tid)); const int lane = tid & 63, wave = __builtin_amdgcn_readfirstlane(tid >> 6);
    (void)tid_in; (void)wave_in; (void)lane_in;
    const int G = gridDim.x, bx = blockIdx.x;
    unsigned char* ws = a.ws;
    if constexpr (PH == 0) p0_prologue(a, lds, tid, wave, lane);
    if constexpr (PH == 1) p1_modulate(a, wave, lane);
    if constexpr (PH == 2) {
        pg8::Gemm g{(const pb*)(ws + WS_H), (const pb*)(ws + WS_WIN), MROWS, INW, DM, LDK}; pg8::GridOrder<1> S; S.init(128, 24, G, bx);
        pg8::EpiIn E{(pb*)(ws + WS_P), (const pg8::f32x2*)(ws + WS_ROPE), (pb*)(ws + WS_VT), (pb*)(ws + WS_VTC), (pb*)(ws + WS_KN), (pb*)(ws + WS_KNC)};
        pg8::gemm_phase<pg8::EpiIn, pg8::GridOrder<1>, false, true, false>(lds, g, S, E);
    }
    if constexpr (PH == 3) { for (int it = bx; it < 256; it += G) r1_block(a, lds, it, tid, wave, lane); }
    if constexpr (PH == 4) {
#pragma unroll 1
        for (int L = bx; L < 1024; L += G) {
            const int id = (L & 7) * 128 + (L >> 3), bh = id >> 3, rq = id & 7, b = bh >> 3, h = bh & 7;
            {
                const GAS char* ksrc = (const GAS char*)(ws + WS_KNC) + (size_t)(b * 8 + h) * 65536; const GAS char* vsrc = (const GAS char*)(ws + WS_VTC) + (size_t)(b * 8 + h) * 65536;
                bf16x8 kv[8], vv[8];
#pragma unroll
                for (int j = 0; j < 8; ++j) { const int idx = tid + NTHR * j; kv[j] = *(const GAS bf16x8*)(ksrc + (size_t)idx * 16); vv[j] = *(const GAS bf16x8*)(vsrc + (size_t)idx * 16); }
#pragma unroll
                for (int j = 0; j < 8; ++j) { const int idx = tid + NTHR * j, key = (idx >> 7) * 8 + ((idx >> 2) & 7), dch = ((idx >> 5) & 3) * 4 + (idx & 3);
                    *(LAS bf16x8*)(lds + NA_KC_OFF + key * NA_KC_PITCH + 16 * dch) = kv[j]; }
#pragma unroll
                for (int j = 0; j < 8; ++j) { const int idx = tid + NTHR * j, gr = idx >> 7, vd = idx & 127; *(LAS bf16x8*)(lds + NA_VC_OFF + vd * NA_VC_PITCH + 16 * gr) = vv[j]; }
                LAS float* rpbs = (LAS float*)(lds + NA_RPB_OFF);
                if (tid < 15 * 31) rpbs[tid] = a.in[11][h * 15 * 31 + tid];
            }
            __syncthreads();
            { int ln = lane; asm volatile("" : "+v"(ln)); na_wave(a, lds, b, h, 4 * rq + 2 * (wave >> 2), wave & 3, ln); }
            __syncthreads();
        }
#pragma unroll 1
        for (int t = bx; t < 256; t += G) {
            const int bh = (t & 7) * 16 + (t >> 4), half = (t >> 3) & 1, b = bh >> 3, h = bh & 7;
            R2Regs rr; r2_load(a, rr, b, h, half * 8, tid);
#pragma unroll 1
            for (int i = 0; i < 8; ++i) { const int c = half * 8 + i;
                r2_store(rr, lds, tid);
                __syncthreads();
                if (i + 1 < 8) r2_load(a, rr, b, h, c + 1, tid);
                { int ln = lane; asm volatile("" : "+v"(ln)); r2_wave(a, lds, b, h, c, wave, ln); }
                __syncthreads(); }
        }
    }
    if constexpr (PH == 5) { pg8::Gemm g{(const pb*)(ws + WS_MIX), (const pb*)(ws + WS_WOUT), NTOK, DM, DM, LDK}; pg8::GridOrder<0, 4> S; S.init(128, 8, G, bx);
        pg8::EpiPlain E{(pb*)(ws + WS_Y), DM}; pg8::gemm_phase<pg8::EpiPlain, pg8::GridOrder<0, 4>, false, true, false>(lds, g, S, E); }
    if constexpr (PH == 6) p6_rows(a, wave, lane);
    if constexpr (PH == 7) { pg8::Gemm g{(const pb*)(ws + WS_H), (const pb*)(ws + WS_WGU), NTOK, NGU, DM, LDK}; pg8::GridOrder<0> S; S.init(128, 44, G, bx);
        pg8::EpiSwiglu E{(pb*)(ws + WS_HID), LDF}; pg8::gemm_phase<pg8::EpiSwiglu, pg8::GridOrder<0>, false, true, false>(lds, g, S, E); }
    if constexpr (PH == 8) { pg8::Gemm g{(const pb*)(ws + WS_HID), (const pb*)(ws + WS_WD), NTOK, DM, DFF, LDF}; pg8::GridOrder<0, 4, true> S; S.init(128, 8, G, bx);
        pg8::EpiPlain E{(pb*)(ws + WS_MIX), DM}; pg8::gemm_phase<pg8::EpiPlain, pg8::GridOrder<0, 4, true>, false, true, false>(lds, g, S, E); }
    if constexpr (PH == 9) p9_rows(a, wave, lane);
}
template <bool CG_SEAM, int FIRST, int... REST> __device__ __forceinline__ void run_prog(const Args& a, LAS unsigned char* lds, const XcdBarrier& bar, int tid, int wave, int lane) {
    if constexpr ((MK_REP_MASK >> FIRST) & 1) {
#pragma unroll 1
        for (int rep = 0; rep < a.pad0; ++rep) { if (rep) xcd_barrier(bar); run_phase<FIRST>(a, lds, tid, wave, lane); }
    } else run_phase<FIRST>(a, lds, tid, wave, lane);
    if constexpr (sizeof...(REST) > 0) {
        xcd_barrier(bar);
        if constexpr (CG_SEAM) { if (a.pad1 == 0x5eed) cg::this_grid().sync(); }
        run_prog<false, REST...>(a, lds, bar, tid, wave, lane); }
}
#ifndef MK_PROG
#define MK_PROG 0, 1, 2, 3, 4, 5, 6, 7, 8, 9
#endif
__global__ void __launch_bounds__(NTHR, 2) fwd_kernel(Args a) {
    extern __shared__ __attribute__((aligned(16))) unsigned char lds_raw[];
    LAS unsigned char* lds = (LAS unsigned char*)lds_raw;
    const int tid = threadIdx.x, lane = tid & 63, wave = __builtin_amdgcn_readfirstlane(tid >> 6);
    volatile LAS unsigned* st = (volatile LAS unsigned*)(lds + LDS_BARST_OFF);
    if (tid < 2) st[tid] = 0u;
    __syncthreads();
    const XcdBarrier bar = xcd_barrier_post((unsigned*)(a.ws + WS_BAR), st);
    run_prog<true, MK_PROG>(a, lds, bar, tid, wave, lane);
}

template <int PH> __global__ void __launch_bounds__(NTHR, 2) phase_kernel(Args a) {
    extern __shared__ __attribute__((aligned(16))) unsigned char lds_raw[];
    LAS unsigned char* lds = (LAS unsigned char*)lds_raw;
    const int tid = threadIdx.x, lane = tid & 63, wave = __builtin_amdgcn_readfirstlane(tid >> 6);
    run_phase<PH>(a, lds, tid, wave, lane);
}
#ifndef MK_PROBE_MASK
#define MK_PROBE_MASK 0
#endif
template <int PH> static void launch_phase(const Args& a, int grid, void* d_ws, hipStream_t stream) {
    const int n = ((MK_PROBE_MASK >> PH) & 1) ? 2 : 1;
    for (int r = 0; r < n; ++r) {
        if (PH == 0) (void)hipMemsetAsync((char*)d_ws + WS_M, 0, WS_M_BYTES, stream);
        (void)hipFuncSetAttribute((const void*)phase_kernel<PH>, hipFuncAttributeMaxDynamicSharedMemorySize, LDS_BYTES);
        hipLaunchKernelGGL(phase_kernel<PH>, dim3(grid), dim3(NTHR), LDS_BYTES, stream, a);
    }
}
extern "C" void kernel_launch(void* const* d_in, const int* in_sizes, int n_in, void* d_out, int out_size, void* d_ws, size_t ws_size, hipStream_t stream) {
    static int grid = 0;
    if (grid == 0) {
        if (n_in != 18 || out_size != NTOK * DM || ws_size < WS_END) { fprintf(stderr, "kernel_launch: unexpected shapes (n_in %d out %d ws %zu)\n", n_in, out_size, ws_size); grid = -1; return; }
        int dev = 0, cus = 0, per_cu = 0;
        (void)hipGetDevice(&dev); (void)hipDeviceGetAttribute(&cus, hipDeviceAttributeMultiprocessorCount, dev);
        if (hipFuncSetAttribute((const void*)fwd_kernel, hipFuncAttributeMaxDynamicSharedMemorySize, LDS_BYTES) != hipSuccess) { fprintf(stderr, "kernel_launch: hipFuncSetAttribute failed\n"); grid = -1; return; }
        if (hipOccupancyMaxActiveBlocksPerMultiprocessor(&per_cu, (const void*)fwd_kernel, NTHR, LDS_BYTES) != hipSuccess || per_cu < 1) { fprintf(stderr, "kernel_launch: occupancy query says %d\n", per_cu); per_cu = 1; }
        (void)hipGetLastError();
        grid = cus > 0 ? cus : 256;
        if (grid % 8 != 0) grid -= grid % 8;
    }
    if (grid < 0) return;
    (void)hipMemsetAsync((char*)d_ws, 0, WS_ZERO_BYTES, stream);
    Args a{};
    for (int i = 0; i < 18; ++i) a.in[i] = (const float*)d_in[i];
    a.out = (float*)d_out; a.ws = (unsigned char*)d_ws; a.pad0 = 2;
#if MK_PROBE_MASK != 0
    launch_phase<0>(a, grid, d_ws, stream); launch_phase<1>(a, grid, d_ws, stream); launch_phase<2>(a, grid, d_ws, stream); launch_phase<3>(a, grid, d_ws, stream); launch_phase<4>(a, grid, d_ws, stream);
    launch_phase<5>(a, grid, d_ws, stream); launch_phase<6>(a, grid, d_ws, stream); launch_phase<7>(a, grid, d_ws, stream);
    launch_phase<8>(a, grid, d_ws, stream); launch_phase<9>(a, grid, d_ws, stream);
    return;
#endif
    void* args[] = {&a};
    hipError_t e = hipLaunchCooperativeKernel((const void*)fwd_kernel, dim3(grid), dim3(NTHR), args, LDS_BYTES, stream);
    if (e != hipSuccess) fprintf(stderr, "kernel_launch: cooperative launch failed: %s (grid %d)\n", hipGetErrorString(e), grid);
}
```

```cpp
#include <hip/hip_runtime.h>
#include <hip/hip_cooperative_groups.h>
#include <cstdio>
#include <cstdint>
namespace cg = cooperative_groups;
namespace pg8 {
#define PG8_LAS __attribute__((address_space(3)))
typedef unsigned short bf16_t;
typedef short bf16x8 __attribute__((ext_vector_type(8)));
typedef float f32x4 __attribute__((ext_vector_type(4)));
typedef unsigned u32x4 __attribute__((ext_vector_type(4)));
constexpr int BM = 256, BK = 64, HALF = 128, HTB = HALF * BK * 2  , STAGE_BYTES = 8 * HTB, NXCD = 8, WGM = 8;

__host__ __device__ __forceinline__ int lds_byte(int r, int c) { const int st = (r >> 4) * 2 + (c >> 5), rr = r & 15, cc = c & 31, ob = rr * 64 + cc * 2; return st * 1024 + (ob ^ (((ob >> 9) & 1) << 5)); }
__host__ __device__ __forceinline__ void stage_rc(int b, int& R, int& C) { const int st = b / 1024, sb = b % 1024, swz = sb ^ (((sb >> 9) & 1) << 5); R = (st >> 1) * 16 + swz / 64; C = (st & 1) * 32 + (swz % 64) / 2; }
__host__ __device__ __forceinline__ int perm32(int rho) { const int n = rho >> 4, i = rho & 15; return 8 * (i >> 2) + 4 * n + (i & 3); }

struct Unit { int pm, pn; };
struct Gemm { const bf16_t* A; const bf16_t* Bt; int M, N, K, ld; };

struct StaticOrder {
    int nM, nN, nwg, G, c;
    __host__ __device__ void init(int M, int N, int G_, int c_) { nM = M / BM; nN = N / BM; nwg = nM * nN; G = G_; c = c_; }
    __host__ __device__ bool next(int i, Unit& u) const {
        const long L = (long)i * G + c; if (L >= nwg) return false;
        int wgid = (int)L; { const int q = nwg / NXCD, r = nwg % NXCD, xcd = wgid % NXCD, off = wgid / NXCD; wgid = (xcd < r ? xcd * (q + 1) : r * (q + 1) + (xcd - r) * q) + off; }
        const int nig = WGM * nN, gid = wgid / nig, fm = gid * WGM, gsz = (nM - fm) < WGM ? (nM - fm) : WGM;
        u.pm = fm + ((wgid % nig) % gsz); u.pn = (wgid % nig) / gsz; return true;
    }
    __device__ __forceinline__ void a_ready(const Unit&) const {}
    __device__ __forceinline__ void done(const Unit&) const {}
};

__device__ __forceinline__ unsigned cvt_pk_bf16(float lo, float hi) { unsigned r; asm volatile("v_cvt_pk_bf16_f32 %0, %1, %2" : "=v"(r) : "v"(lo), "v"(hi)); return r; }
typedef unsigned u32x2 __attribute__((ext_vector_type(2)));
typedef float f32x2 __attribute__((ext_vector_type(2)));
#define PG8_GAS __attribute__((address_space(1)))
constexpr int PWP = 3072 + 64;

template <int MODE, int GM = WGM, bool REV = false> struct GridOrder {
    int nM, nS, G, c;
    __device__ __forceinline__ void init(int nM_, int nS_, int G_, int c_) { nM = nM_; nS = nS_; G = G_; c = c_; }
    __device__ __forceinline__ bool next(int i, Unit& u) const {
        const int nwg = nM * nS; const int nr = (nwg + G - 1) / G; if (REV && i >= nr) return false; const long L = (long)(REV ? nr - 1 - i : i) * G + c; int pm, s;
        if (L < nwg) {
            int wgid = (int)L; { const int q = nwg / NXCD, r = nwg % NXCD, xcd = wgid % NXCD, off = wgid / NXCD; wgid = (xcd < r ? xcd * (q + 1) : r * (q + 1) + (xcd - r) * q) + off; }
            const int nig = GM * nS, gid = wgid / nig, fm = gid * GM, gsz = (nM - fm) < GM ? (nM - fm) : GM;
            pm = fm + ((wgid % nig) % gsz); s = (wgid % nig) / gsz;
            if (MODE == 2) s = s < 4 ? s + 8 : s + 12;
        } else if (MODE == 1 && L < nwg + 224) {
            const int l2 = (int)(L - nwg); pm = 128 + (l2 & 15); s = l2 >> 4; s = s < 8 ? s + 4 : s + 6;
        } else return false;
        u.pm = pm; u.pn = s; return true;
    }
    __device__ __forceinline__ void a_ready(const Unit&) const {}
    __device__ __forceinline__ void done(const Unit&) const {}
};

__device__ __forceinline__ float silu_f(float g) { return g * __builtin_amdgcn_rcpf(1.0f + __builtin_amdgcn_exp2f(-1.44269504089f * g)); }

struct EpiPlain {
    static constexpr bool PERM = true, AFTER_DRAIN = false;
    bf16_t* O; int ldc;
    __device__ __forceinline__ void operator()(const f32x4 (&acc)[2][2][4][2], const Unit& u, int wr, int wc, int fr, int fq) const {
        const int row0 = u.pm * BM + wr * 64 + fr, col0 = u.pn * BM + wc * 32 + 8 * fq;
#pragma unroll
        for (int ai = 0; ai < 2; ++ai)
#pragma unroll
            for (int m = 0; m < 4; ++m) { bf16_t* rowp = O + (size_t)(row0 + ai * HALF + m * 16) * ldc + col0;
#pragma unroll
                for (int bj = 0; bj < 2; ++bj) { const f32x4 v0 = acc[ai][bj][m][0], v1 = acc[ai][bj][m][1];
                    u32x4 w; w.x = cvt_pk_bf16(v0[0], v0[1]); w.y = cvt_pk_bf16(v0[2], v0[3]); w.z = cvt_pk_bf16(v1[0], v1[1]); w.w = cvt_pk_bf16(v1[2], v1[3]);
                    *(PG8_GAS u32x4*)(rowp + bj * HALF) = w; } }
    }
};

struct EpiSwiglu {
    static constexpr bool PERM = true, AFTER_DRAIN = false;
    bf16_t* O; int ldc;
    __device__ __forceinline__ void operator()(const f32x4 (&acc)[2][2][4][2], const Unit& u, int wr, int wc, int fr, int fq) const {
        const int row0 = u.pm * BM + wr * 64 + fr, col0 = u.pn * HALF + wc * 32 + 8 * fq;
#pragma unroll
        for (int ai = 0; ai < 2; ++ai)
#pragma unroll
            for (int m = 0; m < 4; ++m) { bf16_t* rowp = O + (size_t)(row0 + ai * HALF + m * 16) * ldc + col0;
                const f32x4 g0 = acc[ai][0][m][0], g1 = acc[ai][0][m][1], u0 = acc[ai][1][m][0], u1 = acc[ai][1][m][1];
                float h[8];
#pragma unroll
                for (int e = 0; e < 4; ++e) { h[e] = silu_f(g0[e]) * u0[e]; h[4 + e] = silu_f(g1[e]) * u1[e]; }
                u32x4 w; w.x = cvt_pk_bf16(h[0], h[1]); w.y = cvt_pk_bf16(h[2], h[3]); w.z = cvt_pk_bf16(h[4], h[5]); w.w = cvt_pk_bf16(h[6], h[7]);
                *(PG8_GAS u32x4*)rowp = w; }
    }
};

struct EpiIn {
    static constexpr bool PERM = true, AFTER_DRAIN = false;
    bf16_t* P; const f32x2* rope;
    bf16_t* Vt; bf16_t* Vtc;
    bf16_t* Kn; bf16_t* Knc;
    __device__ __forceinline__ void store_vt(const f32x4 (&acc)[2][2][4][2], const Unit& u, int wr, int wc, int fr, int fq) const {
        const int which = u.pn >= 16 ? 1 : 0, j = fr & 3, odd = j & 1, hi2 = (j >> 1) & 1;
        const int cb0 = (u.pn - (which ? 16 : 8)) * BM + wc * 32 + 8 * fq + (odd ? 4 : 0) + (hi2 ? 2 : 0);
        const bool lat = u.pm < 128;
#pragma unroll
        for (int ai = 0; ai < 2; ++ai)
#pragma unroll
            for (int m = 0; m < 4; ++m) { const int row = u.pm * BM + ai * HALF + wr * 64 + m * 16 + (fr & ~3);
                int b, t, ng; bf16_t* base;
                if (lat) { b = row >> 11; t = row & 2047; ng = 256; base = Vt; } else { const int r2 = row - 32768; b = r2 >> 8; t = r2 & 255; ng = 32; base = Vtc; }
#pragma unroll
                for (int bj = 0; bj < 2; ++bj) { float v[8];
#pragma unroll
                    for (int e = 0; e < 4; ++e) { v[e] = acc[ai][bj][m][0][e]; v[4 + e] = acc[ai][bj][m][1][e]; }
                    unsigned pr[4];
#pragma unroll
                    for (int i = 0; i < 4; ++i) { const float snd = odd ? v[i] : v[4 + i]; const float rcv = __shfl_xor(snd, 1);
                        pr[i] = odd ? cvt_pk_bf16(rcv, v[4 + i]) : cvt_pk_bf16(v[i], rcv); }
#pragma unroll
                    for (int k = 0; k < 2; ++k) { const unsigned snd = hi2 ? pr[k] : pr[2 + k]; const unsigned rcv = (unsigned)__shfl_xor((int)snd, 2);
                        u32x2 w; w.x = hi2 ? rcv : pr[k]; w.y = hi2 ? pr[2 + k] : rcv;
                        const int vcol = cb0 + bj * HALF + k; const int head = vcol >> 7, vd = vcol & 127;
                        *(PG8_GAS u32x2*)((PG8_GAS char*)base + ((size_t)(which * 128 + b * 8 + head) * ng + (t >> 3)) * 2048 + vd * 16 + (t & 7) * 2) = w; } } }
    }
    __device__ __forceinline__ void store_kn(const f32x4 (&acc)[2][2][4][2], const Unit& u, int wr, int wc, int fr, int fq) const {
        const bool lat = u.pm < 128;
#pragma unroll
        for (int ai = 0; ai < 2; ++ai)
#pragma unroll
            for (int m = 0; m < 4; ++m) { const int row = u.pm * BM + ai * HALF + wr * 64 + m * 16 + fr;
                int b, t, ng; bf16_t* base;
                if (lat) { b = row >> 11; t = row & 2047; ng = 256; base = Kn; } else { const int r2 = row - 32768; b = r2 >> 8; t = r2 & 255; ng = 32; base = Knc; }
#pragma unroll
                for (int bj = 0; bj < 2; ++bj) { const int head = (u.pn - 4) * 2 + bj; const f32x4 v0 = acc[ai][bj][m][0], v1 = acc[ai][bj][m][1];
                    u32x4 w; w.x = cvt_pk_bf16(v0[0], v0[1]); w.y = cvt_pk_bf16(v0[2], v0[3]); w.z = cvt_pk_bf16(v1[0], v1[1]); w.w = cvt_pk_bf16(v1[2], v1[3]);
                    *(PG8_GAS u32x4*)((PG8_GAS char*)base + ((size_t)(b * 8 + head) * ng + (t >> 3)) * 2048 + wc * 512 + (t & 7) * 64 + fq * 16) = w; } }
    }
    __device__ __forceinline__ void operator()(const f32x4 (&acc)[2][2][4][2], const Unit& u, int wr, int wc, int fr, int fq) const {
        if ((u.pn >= 8 && u.pn < 12) || (u.pn >= 16 && u.pn < 20)) { store_vt(acc, u, wr, wc, fr, fq); return; }
        if (u.pn >= 4 && u.pn < 8) { store_kn(acc, u, wr, wc, fr, fq); return; }
        const int pn = u.pn, slot = pn < 4 ? pn : (pn < 16 ? pn - 8 : pn - 12);
        const int row0 = u.pm * BM + wr * 64 + fr, col0 = slot * BM + wc * 32 + 8 * fq;
        const bool do_rope = (pn >= 12) && (pn < 16) && (u.pm < 128);
        const float qs = (pn == 12 || pn == 13) ? 0.125f : 1.0f;
        const float sgn = fq < 2 ? -1.0f : 1.0f;
#pragma unroll
        for (int ai = 0; ai < 2; ++ai)
#pragma unroll
            for (int m = 0; m < 4; ++m) { const int row = row0 + ai * HALF + m * 16; bf16_t* rowp = P + (size_t)row * PWP + col0;
                const int t = row & 2047, pos = (wc & 1) ? (t & 63) : (t >> 6);
                const PG8_GAS f32x4* rp = (const PG8_GAS f32x4*)(rope + pos * 16 + 8 * (fq & 1));
#pragma unroll
                for (int bj = 0; bj < 2; ++bj) { float v[8];
#pragma unroll
                    for (int e = 0; e < 4; ++e) { v[e] = acc[ai][bj][m][0][e]; v[4 + e] = acc[ai][bj][m][1][e]; }
                    if (do_rope) {
#pragma unroll
                        for (int e2 = 0; e2 < 4; ++e2) { const f32x4 cs = rp[e2];
                            const float p0 = __shfl_xor(v[2 * e2], 32), p1 = __shfl_xor(v[2 * e2 + 1], 32);
                            v[2 * e2] = v[2 * e2] * cs[0] + sgn * p0 * cs[1]; v[2 * e2 + 1] = v[2 * e2 + 1] * cs[2] + sgn * p1 * cs[3]; }
                    }
                    u32x4 w; w.x = cvt_pk_bf16(v[0] * qs, v[1] * qs); w.y = cvt_pk_bf16(v[2] * qs, v[3] * qs); w.z = cvt_pk_bf16(v[4] * qs, v[5] * qs); w.w = cvt_pk_bf16(v[6] * qs, v[7] * qs);
                    *(PG8_GAS u32x4*)(rowp + bj * HALF) = w; } }
    }
};

template <class Epi, class Sched, bool ALIGN_EPI = false, bool SP2 = false, bool TR = false>
__device__ __forceinline__ void gemm_phase(PG8_LAS unsigned char* lds, const Gemm g, const Sched& S, const Epi& E) {
    int tid_ = threadIdx.x; asm volatile("" : "+v"(tid_));
    const int tid = tid_, wid = __builtin_amdgcn_readfirstlane(tid >> 6), lane = tid & 63, wr = wid >> 2, wc = wid & 3, fr = lane & 15, fq = lane >> 4;
    const int K = g.K, nt = K / BK;
    unsigned voffA[2], voffB[2];
#pragma unroll
    for (int i = 0; i < 2; ++i) { int R, C; stage_rc(tid * 16 + i * 8192, R, C); const int Rb = Epi::PERM ? ((R & ~31) + perm32(R & 31)) : R;
        voffA[i] = (unsigned)(R * g.ld + C) * 2u; voffB[i] = (unsigned)(Rb * g.ld + C) * 2u; }
    const size_t kstep = (size_t)(BK * 2);
    const size_t hstep = (size_t)HALF * g.ld * 2;
    const size_t tstep = 2 * hstep;
    const unsigned ldsw = (unsigned)wid * 1024u;
    const int aoff = lds_byte(wr * 64 + fr, fq * 8), boff = lds_byte(wc * 32 + fr, fq * 8);
#define PG8_SA(b, h) (((b) * 2 + (h)) * HTB)
#define PG8_SB(b, h) ((4 + (b) * 2 + (h)) * HTB)
#define PG8_STAGE(bufoff, gbase, voff) do { _Pragma("unroll") for (int _i = 0; _i < 2; ++_i) \
        __builtin_amdgcn_global_load_lds((const unsigned*)((const char*)(gbase) + (voff)[_i]), (PG8_LAS unsigned*)(lds + (bufoff) + ldsw + _i * 8192), 16, 0, 0); } while (0)
#define PG8_LDA(dst, b, h) do { _Pragma("unroll") for (int m = 0; m < 4; ++m) _Pragma("unroll") for (int k = 0; k < 2; ++k) dst[m][k] = *(const PG8_LAS bf16x8*)(lds + PG8_SA(b, h) + aoff + m * 2048 + k * 1024); } while (0)
#define PG8_LDB(dst, b, h) do { _Pragma("unroll") for (int n = 0; n < 2; ++n) _Pragma("unroll") for (int k = 0; k < 2; ++k) dst[n][k] = *(const PG8_LAS bf16x8*)(lds + PG8_SB(b, h) + boff + n * 2048 + k * 1024); } while (0)
#define PG8_MMA(ai, bj, At, Bt) do { __builtin_amdgcn_s_setprio(1); _Pragma("unroll") for (int m = 0; m < 4; ++m) _Pragma("unroll") for (int n = 0; n < 2; ++n) _Pragma("unroll") for (int k = 0; k < 2; ++k) \
        acc[ai][bj][m][n] = TR ? __builtin_amdgcn_mfma_f32_16x16x32_bf16(At[m][k], Bt[n][k], acc[ai][bj][m][n], 0, 0, 0) : __builtin_amdgcn_mfma_f32_16x16x32_bf16(Bt[n][k], At[m][k], acc[ai][bj][m][n], 0, 0, 0); __builtin_amdgcn_s_setprio(0); } while (0)
#define PG8_WAIT_V(n) asm volatile("s_waitcnt vmcnt(" #n ")" ::: "memory")
#define PG8_WAIT_L(n) asm volatile("s_waitcnt lgkmcnt(" #n ")" ::: "memory")
#define PG8_BAR __builtin_amdgcn_s_barrier()
#define PG8_SCHED __builtin_amdgcn_sched_barrier(0)
    Unit cur, nxt; int ui = 0;
    if (!S.next(0, cur)) return;
    f32x4 acc[2][2][4][2];
#pragma unroll
    for (int a = 0; a < 2; ++a)
#pragma unroll
        for (int b = 0; b < 2; ++b)
#pragma unroll
            for (int m = 0; m < 4; ++m)
#pragma unroll
                for (int n = 0; n < 2; ++n) acc[a][b][m][n] = (f32x4){0.f, 0.f, 0.f, 0.f};
    bf16x8 At[4][2], B0[2][2], B1[2][2];
    const char* cA = (const char*)g.A + (size_t)cur.pm * tstep; const char* cB = (const char*)g.Bt + (size_t)cur.pn * tstep;
    S.a_ready(cur);
    if constexpr (SP2) {
        PG8_STAGE(PG8_SB(0, 0), cB, voffB); PG8_STAGE(PG8_SB(0, 1), cB + hstep, voffB); PG8_STAGE(PG8_SA(0, 0), cA, voffA); PG8_STAGE(PG8_SA(0, 1), cA + hstep, voffA);
        if (wr == 1) PG8_BAR;
        PG8_WAIT_V(2); PG8_BAR;
        PG8_STAGE(PG8_SB(1, 0), cB + kstep, voffB); PG8_STAGE(PG8_SA(1, 0), cA + kstep, voffA); PG8_STAGE(PG8_SB(1, 1), cB + hstep + kstep, voffB);
        PG8_WAIT_V(6); PG8_BAR;
    } else {
        PG8_STAGE(PG8_SB(0, 0), cB, voffB); PG8_STAGE(PG8_SA(0, 0), cA, voffA); PG8_STAGE(PG8_SB(0, 1), cB + hstep, voffB); PG8_STAGE(PG8_SA(0, 1), cA + hstep, voffA);
        if (wr == 1) PG8_BAR;
        PG8_WAIT_V(4); PG8_BAR;
        PG8_STAGE(PG8_SB(1, 0), cB + kstep, voffB); PG8_STAGE(PG8_SA(1, 0), cA + kstep, voffA); PG8_STAGE(PG8_SB(1, 1), cB + hstep + kstep, voffB);
        PG8_WAIT_V(6); PG8_BAR;
    }
    for (;;) {
        const bool has_next = S.next(ui + 1, nxt);
        const char* nA = has_next ? (const char*)g.A + (size_t)nxt.pm * tstep : cA; const char* nB = has_next ? (const char*)g.Bt + (size_t)nxt.pn * tstep : cB;
        for (int t = 0; t < nt; t += 2) {
            const bool last = (t == nt - 2);
            const char* a1 = cA + (size_t)(t + 1) * kstep;
            const char* a2 = last ? nA : cA + (size_t)(t + 2) * kstep; const char* b2 = last ? nB : cB + (size_t)(t + 2) * kstep;
            const char* a3 = a2 + kstep; const char* b3 = b2 + kstep;
            if (last && has_next) S.a_ready(nxt);
            if constexpr (SP2) {
            PG8_LDB(B0, 0, 0); PG8_LDB(B1, 0, 1); PG8_SCHED; PG8_LDA(At, 0, 0); PG8_STAGE(PG8_SA(1, 1), a1 + hstep, voffA);
            PG8_WAIT_V(8); PG8_WAIT_L(0); PG8_BAR; PG8_MMA(0, 0, At, B0); PG8_MMA(0, 1, At, B1); PG8_BAR; PG8_SCHED;
            PG8_LDA(At, 0, 1); PG8_STAGE(PG8_SB(0, 0), b2, voffB); PG8_STAGE(PG8_SB(0, 1), b2 + hstep, voffB); PG8_STAGE(PG8_SA(0, 0), a2, voffA);
            PG8_WAIT_V(8); PG8_WAIT_L(0); PG8_BAR; PG8_MMA(1, 0, At, B0); PG8_MMA(1, 1, At, B1); PG8_BAR; PG8_SCHED;
            PG8_LDB(B0, 1, 0); PG8_LDB(B1, 1, 1); PG8_SCHED; PG8_LDA(At, 1, 0); PG8_STAGE(PG8_SA(0, 1), a2 + hstep, voffA);
            PG8_WAIT_V(8); PG8_WAIT_L(0); PG8_BAR; PG8_MMA(0, 0, At, B0); PG8_MMA(0, 1, At, B1); PG8_BAR; PG8_SCHED;
            PG8_LDA(At, 1, 1); PG8_STAGE(PG8_SB(1, 0), b3, voffB); PG8_STAGE(PG8_SB(1, 1), b3 + hstep, voffB); PG8_STAGE(PG8_SA(1, 0), a3, voffA);
            PG8_WAIT_V(8); PG8_WAIT_L(0); PG8_BAR; PG8_MMA(1, 0, At, B0); PG8_MMA(1, 1, At, B1); PG8_BAR; PG8_SCHED;
            } else {
            PG8_LDB(B0, 0, 0); PG8_SCHED; PG8_LDA(At, 0, 0); PG8_STAGE(PG8_SA(1, 1), a1 + hstep, voffA);
            PG8_WAIT_L(8); PG8_BAR; PG8_WAIT_L(0); PG8_MMA(0, 0, At, B0); PG8_BAR; PG8_SCHED;
            PG8_LDB(B1, 0, 1); PG8_STAGE(PG8_SB(0, 0), b2, voffB);
            PG8_BAR; PG8_WAIT_L(0); PG8_MMA(0, 1, At, B1); PG8_BAR;
            PG8_LDA(At, 0, 1); PG8_STAGE(PG8_SA(0, 0), a2, voffA);
            PG8_BAR; PG8_WAIT_L(0); PG8_MMA(1, 0, At, B0); PG8_BAR; PG8_SCHED;
            PG8_STAGE(PG8_SB(0, 1), b2 + hstep, voffB);
            PG8_WAIT_V(6); PG8_BAR; PG8_MMA(1, 1, At, B1); PG8_BAR;
            PG8_LDB(B0, 1, 0); PG8_SCHED; PG8_LDA(At, 1, 0); PG8_STAGE(PG8_SA(0, 1), a2 + hstep, voffA);
            PG8_WAIT_L(8); PG8_BAR; PG8_WAIT_L(0); PG8_MMA(0, 0, At, B0); PG8_BAR; PG8_SCHED;
            PG8_LDB(B1, 1, 1); PG8_STAGE(PG8_SB(1, 0), b3, voffB);
            PG8_BAR; PG8_WAIT_L(0); PG8_MMA(0, 1, At, B1); PG8_BAR;
            PG8_LDA(At, 1, 1); PG8_STAGE(PG8_SA(1, 0), a3, voffA);
            PG8_BAR; PG8_WAIT_L(0); PG8_MMA(1, 0, At, B0); PG8_BAR; PG8_SCHED;
            PG8_STAGE(PG8_SB(1, 1), b3 + hstep, voffB);
            PG8_WAIT_V(6); PG8_BAR; PG8_MMA(1, 1, At, B1); PG8_BAR;
            }
        }
        if constexpr (ALIGN_EPI) { if (wr == 0) PG8_BAR; }
        if constexpr (!Epi::AFTER_DRAIN) { E(acc, cur, wr, wc, fr, fq); S.done(cur); }
        if (!has_next) break;
#pragma unroll
        for (int a = 0; a < 2; ++a)
#pragma unroll
            for (int b = 0; b < 2; ++b)
#pragma unroll
                for (int m = 0; m < 4; ++m)
#pragma unroll
                    for (int n = 0; n < 2; ++n) acc[a][b][m][n] = (f32x4){0.f, 0.f, 0.f, 0.f};
        cur = nxt; cA = nA; cB = nB; ++ui;
        if constexpr (ALIGN_EPI) { if (wr == 1) PG8_BAR; }
    }
    PG8_WAIT_V(0);
    if constexpr (!ALIGN_EPI) { if (wr == 0) PG8_BAR; }
    PG8_BAR;
    if constexpr (Epi::AFTER_DRAIN) { E.fused(acc, cur, wr, wc, fr, fq, lds, wid, lane); S.done(cur); }
#undef PG8_SA
#undef PG8_SB
#undef PG8_STAGE
#undef PG8_LDA
#undef PG8_LDB
#undef PG8_MMA
#undef PG8_WAIT_V
#undef PG8_WAIT_L
#undef PG8_BAR
#undef PG8_SCHED
}
}

#define GAS __attribute__((address_space(1)))
#define LAS __attribute__((address_space(3)))
typedef unsigned short bf16;
typedef short bf16x8 __attribute__((ext_vector_type(8)));
typedef float f32x4 __attribute__((ext_vector_type(4)));
typedef float f32x2 __attribute__((ext_vector_type(2)));
typedef unsigned u32x4 __attribute__((ext_vector_type(4)));
typedef unsigned u32x2 __attribute__((ext_vector_type(2)));

constexpr int NWAVES = 8, NTHR = 512;
constexpr int DM = 2048, NB = 16, SEQ = 2048, NTOK = NB * SEQ, CTXL = 256, NCTX = NB * CTXL, MROWS = NTOK + NCTX;
constexpr int LDK = 2048 + 64, LDF = 5632 + 64;
constexpr int INW = 6144, PW = pg8::PWP, DFF = 5632, NGU = 2 * DFF;
constexpr int PC_RQ = 1024, PC_RK = 1536, PC_RG = 2048;
constexpr float EPS = 1e-6f;

constexpr size_t MiB = 1u << 20;
constexpr size_t WS_M = 0;
constexpr size_t WS_M_BYTES = 17 * 12288 * 4;
constexpr size_t WS_ROPE = 1 * MiB;
constexpr size_t WS_BAR = 1 * MiB + 65536;
constexpr size_t WS_ZERO_BYTES = 1 * MiB + 131072;
constexpr int LDS_BARST_OFF = 147440;
constexpr size_t WS_WIN = 2 * MiB, WS_WOUT = 27 * MiB, WS_WGU = 36 * MiB, WS_WD = 82 * MiB;
constexpr size_t WS_H = 105 * MiB;
constexpr size_t WS_P = 255 * MiB;
constexpr size_t WS_KN = 476 * MiB, WS_KNC = 540 * MiB;
constexpr size_t WS_VT = 548 * MiB, WS_VTC = 676 * MiB;
constexpr size_t WS_HID = 255 * MiB;
constexpr size_t WS_Y = 896 * MiB;
constexpr size_t WS_MIX = 700 * MiB;
constexpr size_t WS_ST = 832 * MiB;
constexpr size_t WS_END = 1024 * MiB;
static_assert(WS_WIN + (size_t)INW * LDK * 2 <= WS_WOUT && WS_WOUT + (size_t)DM * LDK * 2 <= WS_WGU && WS_WGU + (size_t)NGU * LDK * 2 <= WS_WD && WS_WD + (size_t)DM * LDF * 2 <= WS_H && WS_H + (size_t)MROWS * LDK * 2 <= WS_P, "d_ws map (weights, H)");
static_assert(WS_P + (size_t)MROWS * PW * 2 <= WS_KN && WS_VTC + 16 * MiB <= WS_MIX && WS_HID + (size_t)NTOK * LDF * 2 <= WS_MIX && WS_MIX + (size_t)NTOK * LDK * 2 <= WS_ST, "d_ws map");
constexpr int LDS_BYTES = 147456;

__device__ __forceinline__ float bf2f(unsigned short s) { return __uint_as_float(((unsigned)s) << 16); }
__device__ __forceinline__ unsigned pk2(float lo, float hi) { return pg8::cvt_pk_bf16(lo, hi); }
__device__ __forceinline__ float wave_sum(float v) {
#pragma unroll
    for (int o = 1; o < 64; o <<= 1) v += __shfl_xor(v, o);
    return v;
}
#define MFMA16(a, b, c) __builtin_amdgcn_mfma_f32_16x16x32_bf16((a), (b), (c), 0, 0, 0)
#define LDS_WAIT() asm volatile("s_waitcnt lgkmcnt(0)" ::: "memory")

struct Args { const float* in[18]; float* out; unsigned char* ws; int pad0, pad1, pad2, pad3; };

__device__ __forceinline__ void p0_transpose_item(const float* W, int N, int k0, int n0, bf16* WT, int K, int drow0, LAS float* scr, int lane) {
    const int c4 = lane & 15, r = lane >> 4;
    const GAS f32x4* src = (const GAS f32x4*)(W + (size_t)(k0 + r) * N + n0) + c4;
    f32x4 v[16];
#pragma unroll
    for (int i = 0; i < 16; ++i) v[i] = src[(size_t)i * N];
#pragma unroll
    for (int i = 0; i < 16; ++i) { const int k = 4 * i + r; *(LAS f32x4*)(scr + k * 68 + ((4 * c4 + 8 * (k >> 3)) & 63)) = v[i]; }
    LDS_WAIT(); asm volatile("" ::: "memory");
    const int c = lane & 7, nh = lane >> 3;
#pragma unroll
    for (int jj = 0; jj < 8; ++jj) { const int n = nh + 8 * jj; const LAS float* s = scr + (8 * c) * 68 + ((n + 8 * c) & 63);
        u32x4 o; o.x = pk2(s[0 * 68], s[1 * 68]); o.y = pk2(s[2 * 68], s[3 * 68]); o.z = pk2(s[4 * 68], s[5 * 68]); o.w = pk2(s[6 * 68], s[7 * 68]);
        *(GAS u32x4*)(WT + (size_t)(drow0 + n) * K + k0 + 8 * c) = o; }
    LDS_WAIT(); asm volatile("" ::: "memory");
}

__device__ __forceinline__ void p0_prologue(const Args& a, LAS unsigned char* lds, int tid, int wave, int lane) {
    unsigned char* ws = a.ws;
    const int G = gridDim.x, bx = blockIdx.x;
    if (bx == G - 1 && tid < 16) {
        double w = 1.0; for (int i = 0; i < tid; ++i) w *= 0.5623413251903491;
        const double x2 = w * w; double tc = 1.0, ts = w, c1 = 1.0, s1 = w;
        for (int n = 1; n <= 12; ++n) { tc *= -x2 / (double)((2 * n - 1) * (2 * n)); c1 += tc; ts *= -x2 / (double)((2 * n) * (2 * n + 1)); s1 += ts; }
        double c = 1.0, s = 0.0; f32x2* tab = (f32x2*)(ws + WS_ROPE);
        for (int p = 0; p < 64; ++p) { tab[p * 16 + tid] = (f32x2){(float)c, (float)s}; const double cn = c * c1 - s * s1, sn = s * c1 + c * s1; c = cn; s = sn; }
    }
    if (bx < 192) {
        const int cb = bx % 48, ks = bx / 48;
        LAS float* sc = (LAS float*)lds;
        LAS float* red = (LAS float*)(lds + 36864);
        const float* cin = a.in[1]; const float* cctx = a.in[3];
        for (int idx = tid; idx < 17 * 512; idx += NTHR) { const int b = idx >> 9, k = idx & 511;
            const float cv = b < 16 ? cin[b * DM + 512 * ks + k] : cctx[512 * ks + k]; sc[idx] = cv / (1.0f + __expf(-cv)); }
        for (int idx = tid; idx < 17 * 256; idx += NTHR) red[idx] = 0.f;
        __syncthreads();
        f32x4 acc[17];
#pragma unroll
        for (int b = 0; b < 17; ++b) acc[b] = (f32x4){0.f, 0.f, 0.f, 0.f};
        const GAS f32x4* wp = (const GAS f32x4*)(a.in[4] + (size_t)(512 * ks + 64 * wave) * 12288 + 256 * cb) + lane;
#pragma unroll 8
        for (int kk = 0; kk < 64; ++kk) { const f32x4 w4 = wp[(size_t)kk * 3072];
#pragma unroll
            for (int b = 0; b < 17; ++b) { const float s = sc[b * 512 + 64 * wave + kk]; acc[b] += w4 * s; } }
#pragma unroll
        for (int b = 0; b < 17; ++b)
#pragma unroll
            for (int e = 0; e < 4; ++e) __hip_atomic_fetch_add(red + b * 256 + 4 * lane + e, acc[b][e], __ATOMIC_RELAXED, __HIP_MEMORY_SCOPE_WORKGROUP);
        __syncthreads();
        float* mv = (float*)(ws + WS_M); const float* ab = a.in[5];
        for (int idx = tid; idx < 17 * 256; idx += NTHR) { const int b = idx >> 8, col = idx & 255;
            float v = red[idx]; if (ks == 0) v += ab[256 * cb + col]; atomicAdd(mv + b * 12288 + 256 * cb + col, v); }
        __syncthreads();
    }
    LAS float* scr = (LAS float*)(lds + wave * 17408);
    const int gw = bx * NWAVES + wave, NGW = G * NWAVES;
    constexpr int I_IN = 32 * 96, I_OUT = 32 * 32, I_G = 32 * 88, I_D = 88 * 32, NITEMS = I_IN + I_OUT + 2 * I_G + I_D;
    for (int it = gw; it < NITEMS; it += NGW) {
        int r = it;
        if (r < I_IN) { const int kb = r / 96, nb = r % 96; p0_transpose_item(a.in[10], INW, 64 * kb, 64 * nb, (bf16*)(ws + WS_WIN), LDK, 64 * nb, scr, lane); continue; } r -= I_IN;
        if (r < I_OUT) { const int kb = r / 32, nb = r % 32; p0_transpose_item(a.in[14], DM, 64 * kb, 64 * nb, (bf16*)(ws + WS_WOUT), LDK, 64 * nb, scr, lane); continue; } r -= I_OUT;
        if (r < 2 * I_G) { const int up = r >= I_G; if (up) r -= I_G; const int kb = r / 88, nb = r % 88, n0 = 64 * nb;
            p0_transpose_item(a.in[up ? 16 : 15], DFF, 64 * kb, n0, (bf16*)(ws + WS_WGU), LDK, 256 * (n0 >> 7) + (n0 & 127) + (up ? 128 : 0), scr, lane); continue; } r -= 2 * I_G;
        { const int kb = r / 32, nb = r % 32; p0_transpose_item(a.in[17], DM, 64 * kb, 64 * nb, (bf16*)(ws + WS_WD), LDF, 64 * nb, scr, lane); }
    }
}

__device__ __forceinline__ void p1_modulate(const Args& a, int wave, int lane) {
    const int gw = blockIdx.x * NWAVES + wave, NGW = gridDim.x * NWAVES;
    const float* mv = (const float*)(a.ws + WS_M); bf16* H = (bf16*)(a.ws + WS_H);
    const GAS f32x4* gp = (const GAS f32x4*)a.in[6] + lane;
    for (int row = gw; row < MROWS; row += NGW) {
        const float* src = row < NTOK ? a.in[0] + (size_t)row * DM : a.in[2] + (size_t)(row - NTOK) * DM;
        const int vi = row < NTOK ? (row >> 11) : 16;
        const GAS f32x4* xr = (const GAS f32x4*)src + lane;
        const GAS f32x4* shp = (const GAS f32x4*)(mv + vi * 12288) + lane; const GAS f32x4* scp = (const GAS f32x4*)(mv + vi * 12288 + 2048) + lane;
        f32x4 v[8]; float ss = 0.f;
#pragma unroll
        for (int j = 0; j < 8; ++j) { v[j] = __builtin_nontemporal_load(xr + 64 * j); ss += (v[j].x * v[j].x + v[j].y * v[j].y) + (v[j].z * v[j].z + v[j].w * v[j].w); }
        const float rs = 1.0f / sqrtf(wave_sum(ss) * (1.0f / DM) + EPS);
        GAS u32x2* o = (GAS u32x2*)(H + (size_t)row * LDK) + lane;
#pragma unroll
        for (int j = 0; j < 8; ++j) { const f32x4 g = gp[64 * j], sh = shp[64 * j], sc = scp[64 * j];
            const f32x4 r = v[j] * rs * g * (sc + 1.0f) + sh; u32x2 w; w.x = pk2(r.x, r.y); w.y = pk2(r.z, r.w); o[64 * j] = w; }
    }
}

__device__ __forceinline__ void r1_block(const Args& a, LAS unsigned char* lds, int item, int tid, int wave, int lane) {
    const int b = item >> 4, h = (item >> 1) & 7, dir = item & 1, fr = lane & 15, fq = lane >> 4;
    const bf16* P = (const bf16*)(a.ws + WS_P); const bf16* Vt = (const bf16*)(a.ws + WS_VT); const bf16* Vtc = (const bf16*)(a.ws + WS_VTC); bf16* St = (bf16*)(a.ws + WS_ST);
    const float lg2 = a.in[dir ? 13 : 12][h] * 1.44269504089f;
    const float gC = __builtin_amdgcn_exp2f(128.0f * lg2);
    LAS bf16* Kt = (LAS bf16*)lds;
    f32x4 acc[4];
#pragma unroll
    for (int dt = 0; dt < 4; ++dt) acc[dt] = (f32x4){0.f, 0.f, 0.f, 0.f};
    const int j = tid >> 2, dp = tid & 3;
    const float dec = dir == 0 ? __builtin_amdgcn_exp2f((float)(127 - j) * lg2) : __builtin_amdgcn_exp2f((float)j * lg2);
#define R1_CC(s_) (dir == 0 ? ((s_) >= 2 ? (s_) - 2 : (s_)) : ((s_) >= 2 ? 17 - (s_) : 1 - (s_)))
#define R1_LOAD(s_, K0, K1, BV) do { const bool _lat = (s_) >= 2; const int _cc = R1_CC(s_); \
        const int _tok = _lat ? b * SEQ + 128 * _cc + j : NTOK + b * CTXL + 128 * _cc + j; \
        const GAS bf16x8* _kp = (const GAS bf16x8*)(P + (size_t)_tok * PW + PC_RK + h * 64 + 16 * dp); K0 = _kp[0]; K1 = _kp[1]; \
        const GAS char* _vb = (_lat ? (const GAS char*)Vt + ((size_t)(128 + b * 8 + h) * 256 + 16 * _cc + fq) * 2048 : (const GAS char*)Vtc + ((size_t)(128 + b * 8 + h) * 32 + 16 * _cc + fq) * 2048) + (16 * wave + fr) * 16; \
        _Pragma("unroll") for (int _ks = 0; _ks < 4; ++_ks) BV[_ks] = *(const GAS bf16x8*)(_vb + 8192 * _ks); } while (0)
    bf16x8 k0, k1, bv[4];
    R1_LOAD(0, k0, k1, bv);
#pragma unroll 1
    for (int s = 0; s < 18; ++s) {
        const bool lat = s >= 2; const int cc = R1_CC(s);
        if (lat) { bf16* sp = St + ((size_t)((((b * 8 + h) * 2 + dir) * 16 + cc) * 128 + 16 * wave + fr)) * 64 + 4 * fq;
#pragma unroll
            for (int dt = 0; dt < 4; ++dt) { u32x2 w; w.x = pk2(acc[dt][0], acc[dt][1]); w.y = pk2(acc[dt][2], acc[dt][3]); *(GAS u32x2*)(sp + 16 * dt) = w; } }
#pragma unroll
        for (int x = 0; x < 8; ++x) { Kt[(16 * dp + x) * 136 + j] = (bf16)(pk2(bf2f((unsigned short)k0[x]) * dec, 0.f) & 0xffffu); Kt[(16 * dp + 8 + x) * 136 + j] = (bf16)(pk2(bf2f((unsigned short)k1[x]) * dec, 0.f) & 0xffffu); }
        __syncthreads();
        bf16x8 bc[4];
#pragma unroll
        for (int ks = 0; ks < 4; ++ks) bc[ks] = bv[ks];
        if (s + 1 < 18) R1_LOAD(s + 1, k0, k1, bv);
#pragma unroll
        for (int dt = 0; dt < 4; ++dt) acc[dt] *= gC;
#pragma unroll
        for (int ks = 0; ks < 4; ++ks) {
#pragma unroll
            for (int dt = 0; dt < 4; ++dt) { const bf16x8 av = *(const LAS bf16x8*)(Kt + (16 * dt + fr) * 136 + 32 * ks + 8 * fq); acc[dt] = MFMA16(av, bc[ks], acc[dt]); } }
        __syncthreads();
    }
#undef R1_CC
#undef R1_LOAD
}

#define NA_LD8(dst, ub, vo, s0, s1) do { _Pragma("unroll") for (int _i = 0; _i < 8; ++_i) dst[_i] = *(const GAS bf16x8*)((ub) + (size_t)((_i >> 2) * (s0) + (_i & 3) * (s1)) + (vo)); } while (0)
#define NA_LDV8(dst, ub, vo, s0) do { _Pragma("unroll") for (int _i = 0; _i < 8; ++_i) dst[_i] = *(const GAS bf16x8*)((ub) + (size_t)(_i * (s0)) + (vo)); } while (0)
#define NA_LD8_L(dst, lb, vo, s0, s1) do { _Pragma("unroll") for (int _i = 0; _i < 8; ++_i) dst[_i] = *(const LAS bf16x8*)((lb) + ((_i >> 2) * (s0) + (_i & 3) * (s1)) + (vo)); } while (0)
#define NA_LDV8_L(dst, lb, vo, s0) do { _Pragma("unroll") for (int _i = 0; _i < 8; ++_i) dst[_i] = *(const LAS bf16x8*)((lb) + (_i * (s0)) + (vo)); } while (0)
#define NA_QK(d0, d1, src) do { f32x4 _a = (f32x4){0.f, 0.f, 0.f, 0.f}, _b = _a; _Pragma("unroll") for (int _k = 0; _k < 4; ++_k) { _a = MFMA16(src[_k], qf[_k], _a); _b = MFMA16(src[4 + _k], qf[_k], _b); } d0 = _a; d1 = _b; } while (0)
#define NA_PACK(pf, s0, s1) do { u32x4 _pw; _pw.x = pk2(s0[0], s0[1]); _pw.y = pk2(s0[2], s0[3]); _pw.z = pk2(s1[0], s1[1]); _pw.w = pk2(s1[2], s1[3]); pf = __builtin_bit_cast(bf16x8, _pw); } while (0)
#define NA_PV(src, pf) do { _Pragma("unroll") for (int _v = 0; _v < 8; ++_v) o[_v] = MFMA16(src[_v], pf, o[_v]); } while (0)
constexpr int NA_KC_OFF = 0, NA_KC_PITCH = 272, NA_VC_OFF = 256 * 272, NA_VC_PITCH = 528, NA_RPB_OFF = NA_VC_OFF + 128 * 528;
template <bool LOCAL> __device__ __forceinline__ void na_step(f32x4& s0, f32x4& s1, bool tv, unsigned cmask, const LAS float* brow, float& m, float& l, f32x4 (&o)[8], bf16x8& pf) {
    const float SC = 0.08838834764831845f * 1.44269504089f, L2E = 1.44269504089f, NEG = -1e30f;
    float v[8]; float mx = NEG;
#pragma unroll
    for (int x = 0; x < 8; ++x) { const float raw = x < 4 ? s0[x] : s1[x - 4];
        if (LOCAL) { float bias = brow[x]; asm volatile("" : "+v"(bias)); const bool ok = tv && ((cmask >> x) & 1u); v[x] = ok ? raw * SC + bias * L2E : NEG; }
        else v[x] = raw * SC;
        mx = fmaxf(mx, v[x]); }
    mx = fmaxf(mx, __shfl_xor(mx, 16)); mx = fmaxf(mx, __shfl_xor(mx, 32));
    const float mn = fmaxf(m, mx), sc = __builtin_amdgcn_exp2f(m - mn);
    float ps = 0.f;
#pragma unroll
    for (int x = 0; x < 8; ++x) { float p = __builtin_amdgcn_exp2f(v[x] - mn); if (LOCAL) p = v[x] > -1e29f ? p : 0.f; v[x] = p; ps += p; }
    l = l * sc + ps; m = mn;
    if (__builtin_amdgcn_ballot_w64(sc != 1.0f) != 0ull) {
#pragma unroll
        for (int vt = 0; vt < 8; ++vt) o[vt] = o[vt] * sc; }
    u32x4 pw; pw.x = pk2(v[0], v[1]); pw.y = pk2(v[2], v[3]); pw.z = pk2(v[4], v[5]); pw.w = pk2(v[6], v[7]); pf = __builtin_bit_cast(bf16x8, pw);
}
__device__ __forceinline__ void na_wave(const Args& a, const LAS unsigned char* lds, int b, int h, int r0, int ct, int lane) {
    const LAS float* rpb = (const LAS float*)(lds + NA_RPB_OFF);
    const LAS unsigned char* kcl = lds + NA_KC_OFF; const LAS unsigned char* vcl = lds + NA_VC_OFF;
    const int fr = lane & 15, fq = lane >> 4;
    const bf16* P = (const bf16*)(a.ws + WS_P); const bf16* Vt = (const bf16*)(a.ws + WS_VT); const bf16* Kn = (const bf16*)(a.ws + WS_KN); bf16* MIX = (bf16*)(a.ws + WS_MIX);
    const int c0 = 16 * ct, kc0 = min(max(c0 - 8, 0), 32), rs0 = min(max(r0 - 4, 0), 24), rs1 = min(max(r0 - 3, 0), 24), d = rs1 - rs0;
    const int qtok = b * SEQ + r0 * 64 + c0 + fr;
    bf16x8 qf[2][4];
    { const GAS char* qu = (const GAS char*)P + ((size_t)(b * SEQ + r0 * 64 + c0) * PW + h * 128) * 2; const unsigned qo = (unsigned)(fr * PW + 8 * fq) * 2u;
#pragma unroll
      for (int ks = 0; ks < 4; ++ks) { qf[0][ks] = *(const GAS bf16x8*)(qu + 64 * ks + qo); qf[1][ks] = *(const GAS bf16x8*)(qu + (size_t)64 * PW * 2 + 64 * ks + qo); } }
    const int koff = 8 * (fr >> 2) + (fr & 3);
    const int c = c0 + fr, cs = min(max(c - 8, 0), 48);
    unsigned cmask = 0u;
#pragma unroll
    for (int x = 0; x < 8; ++x) { const int kc = kc0 + 8 * fq + x; if (kc >= cs && kc < cs + 16) cmask |= 1u << x; }
    const int dcb = kc0 + 8 * fq - c + 15;
    const GAS char* kl = (const GAS char*)Kn + ((size_t)(b * 8 + h) * 256 + (rs0 * 64 + kc0) / 8) * 2048;
    const GAS char* vl = (const GAS char*)Vt + ((size_t)(b * 8 + h) * 256 + (rs0 * 64 + kc0) / 8) * 2048;
    const unsigned klo = (unsigned)((fr >> 2) * 2048 + (fr & 3) * 64 + fq * 16), vlo = (unsigned)(fq * 2048 + fr * 16);
    const int kcl_lo = koff * NA_KC_PITCH + 16 * fq, vcl_lo = fr * NA_VC_PITCH + 16 * fq;
    f32x4 o0[8], o1[8];
#pragma unroll
    for (int vt = 0; vt < 8; ++vt) { o0[vt] = (f32x4){0.f, 0.f, 0.f, 0.f}; o1[vt] = o0[vt]; }
    float m0 = -1e30f, m1 = -1e30f, l0 = 0.f, l1 = 0.f;
    bf16x8 fa[8], fb[8];
    const int nkr = 8 + d;
    NA_LDV8(fb, vl, vlo, 256);
#pragma unroll 1
    for (int kr = 0; kr < nkr; ++kr) {
        NA_LD8(fa, kl + (size_t)kr * 16384, klo, 256, 512);
        f32x4 sa0, sa1, sb0, sb1;
        { f32x4 z = (f32x4){0.f, 0.f, 0.f, 0.f}; sa0 = z; sa1 = z; sb0 = z; sb1 = z; }
#pragma unroll
        for (int ks = 0; ks < 4; ++ks) { sa0 = MFMA16(fa[ks], qf[0][ks], sa0); sa1 = MFMA16(fa[4 + ks], qf[0][ks], sa1); sb0 = MFMA16(fa[ks], qf[1][ks], sb0); sb1 = MFMA16(fa[4 + ks], qf[1][ks], sb1); }
        bf16x8 pf0, pf1;
        { const int dr0 = rs0 + kr - r0, dr1 = dr0 - 1;
          na_step<true>(sa0, sa1, kr <= 7, cmask, rpb + min(max(dr0 + 7, 0), 14) * 31 + dcb, m0, l0, o0, pf0);
          na_step<true>(sb0, sb1, kr >= d, cmask, rpb + min(max(dr1 + 7, 0), 14) * 31 + dcb, m1, l1, o1, pf1); }
#pragma unroll
        for (int vt = 0; vt < 8; ++vt) { o0[vt] = MFMA16(fb[vt], pf0, o0[vt]); o1[vt] = MFMA16(fb[vt], pf1, o1[vt]); }
        if (kr + 1 < nkr) NA_LDV8(fb, vl + (size_t)(kr + 1) * 16384, vlo, 256);
    }
#pragma unroll 1
    for (int g = 0; g < 8; ++g) {
        NA_LD8_L(fa, kcl + g * 32 * NA_KC_PITCH, kcl_lo, 4 * NA_KC_PITCH, 64);
        f32x4 sa0, sa1, sb0, sb1;
        { f32x4 z = (f32x4){0.f, 0.f, 0.f, 0.f}; sa0 = z; sa1 = z; sb0 = z; sb1 = z; }
#pragma unroll
        for (int ks = 0; ks < 4; ++ks) { sa0 = MFMA16(fa[ks], qf[0][ks], sa0); sa1 = MFMA16(fa[4 + ks], qf[0][ks], sa1); sb0 = MFMA16(fa[ks], qf[1][ks], sb0); sb1 = MFMA16(fa[4 + ks], qf[1][ks], sb1); }
        NA_LDV8_L(fb, vcl + g * 64, vcl_lo, 16 * NA_VC_PITCH);
        bf16x8 pf0, pf1;
        na_step<false>(sa0, sa1, true, 0xffu, rpb, m0, l0, o0, pf0);
        na_step<false>(sb0, sb1, true, 0xffu, rpb, m1, l1, o1, pf1);
#pragma unroll
        for (int vt = 0; vt < 8; ++vt) { o0[vt] = MFMA16(fb[vt], pf0, o0[vt]); o1[vt] = MFMA16(fb[vt], pf1, o1[vt]); }
    }
    l0 += __shfl_xor(l0, 16); l0 += __shfl_xor(l0, 32); l1 += __shfl_xor(l1, 16); l1 += __shfl_xor(l1, 32);
    const float i0 = 1.0f / l0, i1 = 1.0f / l1;
    bf16* op = MIX + (size_t)qtok * LDK + h * 128 + 4 * fq;
#pragma unroll
    for (int vt = 0; vt < 8; ++vt) { u32x2 w; w.x = pk2(o0[vt][0] * i0, o0[vt][1] * i0); w.y = pk2(o0[vt][2] * i0, o0[vt][3] * i0); *(GAS u32x2*)(op + 16 * vt) = w;
        u32x2 w2; w2.x = pk2(o1[vt][0] * i1, o1[vt][1] * i1); w2.y = pk2(o1[vt][2] * i1, o1[vt][3] * i1); *(GAS u32x2*)(op + (size_t)64 * LDK + 16 * vt) = w2; }
}

constexpr int R2_K_OFF = 0, R2_K_PITCH = 144, R2_V_OFF = 128 * 144, R2_V_PITCH = 272, R2_SF_OFF = R2_V_OFF + 128 * 272, R2_SB_OFF = R2_SF_OFF + 128 * 144, R2_S_PITCH = 144, R2_LDS_END = R2_SB_OFF + 128 * 144;
struct R2Regs { bf16x8 kv[2], vv[4], sfv[2], sbv[2]; };
__device__ __forceinline__ void r2_load(const Args& a, R2Regs& r, int b, int h, int c, int tid) {
    const bf16* P = (const bf16*)(a.ws + WS_P); const bf16* Vt = (const bf16*)(a.ws + WS_VT); const bf16* St = (const bf16*)(a.ws + WS_ST);
#pragma unroll
    for (int j = 0; j < 2; ++j) { const int idx = tid + NTHR * j, row = idx >> 3, ch = idx & 7;
        r.kv[j] = *(const GAS bf16x8*)(P + (size_t)(b * SEQ + 128 * c + row) * PW + PC_RK + h * 64 + 8 * ch);
        r.sfv[j] = *(const GAS bf16x8*)(St + ((size_t)((((b * 8 + h) * 2 + 0) * 16 + c) * 128 + row)) * 64 + 8 * ch);
        r.sbv[j] = *(const GAS bf16x8*)(St + ((size_t)((((b * 8 + h) * 2 + 1) * 16 + c) * 128 + row)) * 64 + 8 * ch); }
#pragma unroll
    for (int j = 0; j < 4; ++j) { const int idx = tid + NTHR * j;
        r.vv[j] = *(const GAS bf16x8*)((const GAS char*)Vt + ((size_t)(128 + b * 8 + h) * 256 + 16 * c) * 2048 + (size_t)idx * 16); }
}
__device__ __forceinline__ void r2_store(const R2Regs& r, LAS unsigned char* lds, int tid) {
#pragma unroll
    for (int j = 0; j < 2; ++j) { const int idx = tid + NTHR * j, row = idx >> 3, ch = idx & 7;
        *(LAS bf16x8*)(lds + R2_K_OFF + row * R2_K_PITCH + 16 * ch) = r.kv[j]; *(LAS bf16x8*)(lds + R2_SF_OFF + row * R2_S_PITCH + 16 * ch) = r.sfv[j]; *(LAS bf16x8*)(lds + R2_SB_OFF + row * R2_S_PITCH + 16 * ch) = r.sbv[j]; }
#pragma unroll
    for (int j = 0; j < 4; ++j) { const int idx = tid + NTHR * j, gr = idx >> 7, vd = idx & 127; *(LAS bf16x8*)(lds + R2_V_OFF + vd * R2_V_PITCH + 16 * gr) = r.vv[j]; }
}
__device__ __forceinline__ void r2_wave(const Args& a, const LAS unsigned char* lds, int b, int h, int c, int it, int lane) {
    const int fr = lane & 15, fq = lane >> 4;
    const bf16* P = (const bf16*)(a.ws + WS_P); const bf16* Vt = (const bf16*)(a.ws + WS_VT); const bf16* St = (const bf16*)(a.ws + WS_ST); bf16* MIX = (bf16*)(a.ws + WS_MIX);
    const float lgf = a.in[12][h] * 1.44269504089f, lgb = a.in[13][h] * 1.44269504089f;
    const int i = 16 * it + fr, tokq = b * SEQ + 128 * c + i;
    bf16x8 qf[2];
    { const GAS char* qu = (const GAS char*)P + ((size_t)(b * SEQ + 128 * c + 16 * it) * PW + PC_RQ + h * 64) * 2; const unsigned qo = (unsigned)(fr * PW + 8 * fq) * 2u;
      qf[0] = *(const GAS bf16x8*)(qu + qo); qf[1] = *(const GAS bf16x8*)(qu + 64 + qo); }
    const int koff = 8 * (fr >> 2) + (fr & 3);
    const LAS unsigned char* kb = lds + R2_K_OFF;
    const LAS unsigned char* vb = lds + R2_V_OFF;
    const LAS unsigned char* sf = lds + R2_SF_OFF;
    const LAS unsigned char* sb = lds + R2_SB_OFF;
    const int klo = koff * R2_K_PITCH + 16 * fq, vlo = fr * R2_V_PITCH + 16 * fq, slo = fr * R2_S_PITCH + 16 * fq;
    bf16x8 fa[8], fb[8];
#define R2_SB() __builtin_amdgcn_sched_barrier(0)
#pragma unroll
    for (int x = 0; x < 8; ++x) fa[x] = *(const LAS bf16x8*)(kb + (32 * (x >> 2) + 4 * ((x >> 1) & 1)) * R2_K_PITCH + 64 * (x & 1) + klo);
#pragma unroll
    for (int x = 0; x < 8; ++x) fb[x] = *(const LAS bf16x8*)(kb + (64 + 32 * (x >> 2) + 4 * ((x >> 1) & 1)) * R2_K_PITCH + 64 * (x & 1) + klo);
    R2_SB();
    f32x4 s[8];
#pragma unroll
    for (int x = 0; x < 4; ++x) { f32x4 v = (f32x4){0.f, 0.f, 0.f, 0.f}; v = MFMA16(fa[2 * x], qf[0], v); v = MFMA16(fa[2 * x + 1], qf[1], v); s[x] = v; }
    R2_SB();
    NA_LDV8_L(fa, vb, vlo, 16 * R2_V_PITCH);
#pragma unroll
    for (int x = 0; x < 4; ++x) { f32x4 v = (f32x4){0.f, 0.f, 0.f, 0.f}; v = MFMA16(fb[2 * x], qf[0], v); v = MFMA16(fb[2 * x + 1], qf[1], v); s[4 + x] = v; }
    R2_SB();
    NA_LDV8_L(fb, vb + 64, vlo, 16 * R2_V_PITCH);
#pragma unroll
    for (int x = 0; x < 8; ++x)
#pragma unroll
        for (int e = 0; e < 4; ++e) { const int jj = 32 * (x >> 1) + 8 * fq + 4 * (x & 1) + e; const int d = i - jj;
            const float df = d >= 0 ? __builtin_amdgcn_exp2f((float)d * lgf) : 0.f, db = d <= 0 ? __builtin_amdgcn_exp2f((float)(-d) * lgb) : 0.f;
            s[x][e] *= (df + db); }
    R2_SB();
    f32x4 o[8], ox[8];
#pragma unroll
    for (int vt = 0; vt < 8; ++vt) o[vt] = (f32x4){0.f, 0.f, 0.f, 0.f};
    { bf16x8 pf;
      NA_PACK(pf, s[0], s[1]); NA_PV(fa, pf); R2_SB();
      NA_LDV8_L(fa, vb + 128, vlo, 16 * R2_V_PITCH);
      NA_PACK(pf, s[2], s[3]); NA_PV(fb, pf); R2_SB();
      NA_LDV8_L(fb, vb + 192, vlo, 16 * R2_V_PITCH);
      NA_PACK(pf, s[4], s[5]); NA_PV(fa, pf); R2_SB();
      NA_LDV8_L(fa, sf, slo, 16 * R2_S_PITCH);
      NA_PACK(pf, s[6], s[7]); NA_PV(fb, pf); R2_SB(); }
    const float wf = __builtin_amdgcn_exp2f((float)(i + 1) * lgf), wb = __builtin_amdgcn_exp2f((float)(128 - i) * lgb);
    NA_LDV8_L(fb, sf + 64, slo, 16 * R2_S_PITCH);
#pragma unroll
    for (int vt = 0; vt < 8; ++vt) ox[vt] = MFMA16(fa[vt], qf[0], ((f32x4){0.f, 0.f, 0.f, 0.f}));
    R2_SB();
    NA_LDV8_L(fa, sb, slo, 16 * R2_S_PITCH);
#pragma unroll
    for (int vt = 0; vt < 8; ++vt) ox[vt] = MFMA16(fb[vt], qf[1], ox[vt]);
    R2_SB();
    NA_LDV8_L(fb, sb + 64, slo, 16 * R2_S_PITCH);
#pragma unroll
    for (int vt = 0; vt < 8; ++vt) { o[vt] = o[vt] + ox[vt] * wf; ox[vt] = MFMA16(fa[vt], qf[0], ((f32x4){0.f, 0.f, 0.f, 0.f})); }
    R2_SB();
#pragma unroll
    for (int vt = 0; vt < 8; ++vt) ox[vt] = MFMA16(fb[vt], qf[1], ox[vt]);
#pragma unroll
    for (int vt = 0; vt < 8; ++vt) o[vt] = o[vt] + ox[vt] * wb;
    R2_SB();
#undef R2_SB
    float sum = 0.f;
#pragma unroll
    for (int vt = 0; vt < 8; ++vt) { sum += (o[vt][0] + o[vt][1]) + (o[vt][2] + o[vt][3]); }
    sum += __shfl_xor(sum, 16); sum += __shfl_xor(sum, 32);
    const float mu = sum * (1.0f / 128.0f); float q = 0.f;
#pragma unroll
    for (int vt = 0; vt < 8; ++vt) { o[vt] = o[vt] - mu; q += (o[vt][0] * o[vt][0] + o[vt][1] * o[vt][1]) + (o[vt][2] * o[vt][2] + o[vt][3] * o[vt][3]); }
    q += __shfl_xor(q, 16); q += __shfl_xor(q, 32);
    const float rstd = 1.0f / sqrtf(q * (1.0f / 128.0f) + EPS);
    const GAS u32x2* gp = (const GAS u32x2*)(P + (size_t)tokq * PW + PC_RG + h * 128 + 4 * fq);
    bf16* op = MIX + (size_t)tokq * LDK + 1024 + h * 128 + 4 * fq;
    u32x2 gw[8];
#pragma unroll
    for (int vt = 0; vt < 8; ++vt) gw[vt] = gp[4 * vt];
#pragma unroll
    for (int vt = 0; vt < 8; ++vt) {
        const float g0 = __uint_as_float(gw[vt].x << 16), g1 = __uint_as_float(gw[vt].x & 0xffff0000u), g2 = __uint_as_float(gw[vt].y << 16), g3 = __uint_as_float(gw[vt].y & 0xffff0000u);
        u32x2 w; w.x = pk2(o[vt][0] * rstd * pg8::silu_f(g0), o[vt][1] * rstd * pg8::silu_f(g1)); w.y = pk2(o[vt][2] * rstd * pg8::silu_f(g2), o[vt][3] * rstd * pg8::silu_f(g3));
        *(GAS u32x2*)(op + 16 * vt) = w; }
}

__device__ __forceinline__ void p6_rows(const Args& a, int wave, int lane) {
    const int gw = blockIdx.x * NWAVES + wave, NGW = gridDim.x * NWAVES;
    const float* mv = (const float*)(a.ws + WS_M); const bf16* Y = (const bf16*)(a.ws + WS_Y); bf16* H = (bf16*)(a.ws + WS_H);
    const GAS f32x4* wpost = (const GAS f32x4*)a.in[7] + lane; const GAS f32x4* wpre = (const GAS f32x4*)a.in[8] + lane;
    for (int row = gw; row < NTOK; row += NGW) {
        const float* mrow = mv + (row >> 11) * 12288;
        const GAS f32x4* g1p = (const GAS f32x4*)(mrow + 4096) + lane; const GAS f32x4* sh2p = (const GAS f32x4*)(mrow + 6144) + lane; const GAS f32x4* sc2p = (const GAS f32x4*)(mrow + 8192) + lane;
        const GAS u32x2* yp = (const GAS u32x2*)(Y + (size_t)row * DM) + lane; const GAS f32x4* xp = (const GAS f32x4*)(a.in[0] + (size_t)row * DM) + lane;
        f32x4 y[8], x[8]; float ss = 0.f;
#pragma unroll
        for (int j = 0; j < 8; ++j) { const u32x2 w = yp[64 * j]; x[j] = __builtin_nontemporal_load(xp + 64 * j);
            y[j] = (f32x4){__uint_as_float(w.x << 16), __uint_as_float(w.x & 0xffff0000u), __uint_as_float(w.y << 16), __uint_as_float(w.y & 0xffff0000u)};
            ss += (y[j].x * y[j].x + y[j].y * y[j].y) + (y[j].z * y[j].z + y[j].w * y[j].w); }
        const float rs = 1.0f / sqrtf(wave_sum(ss) * (1.0f / DM) + EPS);
        float s2 = 0.f;
#pragma unroll
        for (int j = 0; j < 8; ++j) { x[j] = x[j] + g1p[64 * j] * (y[j] * rs * wpost[64 * j]);
            s2 += (x[j].x * x[j].x + x[j].y * x[j].y) + (x[j].z * x[j].z + x[j].w * x[j].w); }
        const float rs2 = 1.0f / sqrtf(wave_sum(s2) * (1.0f / DM) + EPS);
        GAS u32x2* hp = (GAS u32x2*)(H + (size_t)row * LDK) + lane;
#pragma unroll
        for (int j = 0; j < 8; ++j) { const f32x4 r = x[j] * rs2 * wpre[64 * j] * (sc2p[64 * j] + 1.0f) + sh2p[64 * j]; u32x2 w; w.x = pk2(r.x, r.y); w.y = pk2(r.z, r.w); hp[64 * j] = w; }
    }
}
__device__ __forceinline__ void p9_rows(const Args& a, int wave, int lane) {
    const int gw = blockIdx.x * NWAVES + wave, NGW = gridDim.x * NWAVES;
    const float* mv = (const float*)(a.ws + WS_M); const bf16* F = (const bf16*)(a.ws + WS_MIX); const bf16* Y = (const bf16*)(a.ws + WS_Y);
    const GAS f32x4* wpost = (const GAS f32x4*)a.in[9] + lane; const GAS f32x4* wpm = (const GAS f32x4*)a.in[7] + lane;
    for (int row = gw; row < NTOK; row += NGW) {
        const GAS f32x4* g1p = (const GAS f32x4*)(mv + (row >> 11) * 12288 + 4096) + lane; const GAS f32x4* g2p = (const GAS f32x4*)(mv + (row >> 11) * 12288 + 10240) + lane;
        const GAS u32x2* fp = (const GAS u32x2*)(F + (size_t)row * DM) + lane; const GAS u32x2* yp = (const GAS u32x2*)(Y + (size_t)row * DM) + lane;
        const GAS f32x4* xp = (const GAS f32x4*)(a.in[0] + (size_t)row * DM) + lane; GAS f32x4* op = (GAS f32x4*)(a.out + (size_t)row * DM) + lane;
        f32x4 x[8]; u32x2 fw[8], yw[8]; float ssy = 0.f, ssf = 0.f;
#pragma unroll
        for (int j = 0; j < 8; ++j) { x[j] = __builtin_nontemporal_load(xp + 64 * j); fw[j] = __builtin_nontemporal_load(fp + 64 * j); yw[j] = __builtin_nontemporal_load(yp + 64 * j); }
#pragma unroll
        for (int j = 0; j < 8; ++j) {
            const f32x4 y = (f32x4){__uint_as_float(yw[j].x << 16), __uint_as_float(yw[j].x & 0xffff0000u), __uint_as_float(yw[j].y << 16), __uint_as_float(yw[j].y & 0xffff0000u)};
            const f32x4 f = (f32x4){__uint_as_float(fw[j].x << 16), __uint_as_float(fw[j].x & 0xffff0000u), __uint_as_float(fw[j].y << 16), __uint_as_float(fw[j].y & 0xffff0000u)};
            ssy += (y.x * y.x + y.y * y.y) + (y.z * y.z + y.w * y.w); ssf += (f.x * f.x + f.y * f.y) + (f.z * f.z + f.w * f.w); }
        const float rsy = 1.0f / sqrtf(wave_sum(ssy) * (1.0f / DM) + EPS), rsf = 1.0f / sqrtf(wave_sum(ssf) * (1.0f / DM) + EPS);
#pragma unroll
        for (int j = 0; j < 8; ++j) {
            const f32x4 y = (f32x4){__uint_as_float(yw[j].x << 16), __uint_as_float(yw[j].x & 0xffff0000u), __uint_as_float(yw[j].y << 16), __uint_as_float(yw[j].y & 0xffff0000u)};
            const f32x4 f = (f32x4){__uint_as_float(fw[j].x << 16), __uint_as_float(fw[j].x & 0xffff0000u), __uint_as_float(fw[j].y << 16), __uint_as_float(fw[j].y & 0xffff0000u)};
            __builtin_nontemporal_store((x[j] + g1p[64 * j] * (y * rsy * wpm[64 * j])) + g2p[64 * j] * (f * rsf * wpost[64 * j]), op + 64 * j); }
    }
}

#define RLX_AGENT __ATOMIC_RELAXED, __HIP_MEMORY_SCOPE_AGENT
#define XB_TMO      128
#define XB_XCNT(j)  (256  + 64 * (j))
#define XB_XSUB(j)  (1280 + 64 * (j))
#define XB_XGEN(j)  (2304 + 64 * (j))
#define XB_TOP      3328
#define XB_TOPGEN   3392
#define XCD_BAR_WORDS 3456
#define XB_SPIN_CAP (1u << 18)

__device__ __forceinline__ unsigned xb_ld(unsigned* p)              { return __hip_atomic_load(p, __ATOMIC_RELAXED, __HIP_MEMORY_SCOPE_AGENT); }
__device__ __forceinline__ unsigned xb_add(unsigned* p, unsigned v) { return __hip_atomic_fetch_add(p, v, __ATOMIC_RELAXED, __HIP_MEMORY_SCOPE_AGENT); }
__device__ __forceinline__ unsigned xb_xcc_id() { return (unsigned)__builtin_amdgcn_s_getreg((3 << 11) | 20) & 0xFu; }
#define XB_SPIN(cond, bar) do { unsigned _sp = 0; while (cond) { __builtin_amdgcn_s_sleep(1); \
    if ((++_sp & 255u) == 0u) { if (xb_ld(&(bar)[XB_TMO])) break; if (_sp > XB_SPIN_CAP) { atomicAdd(&(bar)[XB_TMO], 1u); break; } } } } while (0)

struct XcdBarrier {
    unsigned* bar; unsigned x;
    volatile LAS unsigned* st;
};

__device__ __forceinline__ XcdBarrier xcd_barrier_post(unsigned* bar, volatile LAS unsigned* st) {
    XcdBarrier b; b.bar = bar; b.x = xb_xcc_id(); b.st = st;
    if (threadIdx.x == 0) (void)xb_add(&bar[XB_XCNT(b.x)], 1u);
    return b;
}
__device__ __forceinline__ void xcd_barrier_complete(unsigned* bar, unsigned x, unsigned& nloc, unsigned& nx) {
    const unsigned G = gridDim.x * gridDim.y * gridDim.z;
    unsigned sum, cnt, mine, sp = 0u;
    for (;;) {
        sum = 0u; cnt = 0u; mine = 0u;
#pragma unroll
        for (unsigned j = 0; j < 16; ++j) { const unsigned c = xb_ld(&bar[XB_XCNT(j)]); sum += c; cnt += (c > 0u) ? 1u : 0u; mine = (j == x) ? c : mine; }
        if (sum == G) break;
        __builtin_amdgcn_s_sleep(1);
        if ((++sp & 255u) == 0u) { if (xb_ld(&bar[XB_TMO])) break; if (sp > XB_SPIN_CAP) { atomicAdd(&bar[XB_TMO], 1u); break; } }
    }
    nloc = mine > 0u ? mine : 1u; nx = cnt > 0u ? cnt : 1u;
}

__device__ __forceinline__ void xcd_barrier(const XcdBarrier& b) {
    asm volatile("s_waitcnt vmcnt(0)" ::: "memory");
    __syncthreads();
    if (threadIdx.x == 0) {
        unsigned* bar = b.bar;
        __builtin_amdgcn_s_waitcnt(0);
        unsigned nloc = b.st[0], nx = b.st[1];
        if (nloc == 0u) { xcd_barrier_complete(bar, b.x, nloc, nx); b.st[0] = nloc; b.st[1] = nx; }
        const unsigned old = xb_add(&bar[XB_XSUB(b.x)], 1u);
        const unsigned gen = old / nloc;
        if (old + 1u == (gen + 1u) * nloc) {
            __builtin_amdgcn_fence(__ATOMIC_RELEASE, "agent");
            asm volatile("s_waitcnt vmcnt(0)" ::: "memory");
            const unsigned og = xb_add(&bar[XB_TOP], 1u);
            const unsigned tg = og / nx;
            if (og + 1u == (tg + 1u) * nx) xb_add(&bar[XB_TOPGEN], 1u);
            else XB_SPIN(xb_ld(&bar[XB_TOPGEN]) == tg, bar);
            __builtin_amdgcn_fence(__ATOMIC_ACQUIRE, "agent");
            xb_add(&bar[XB_XGEN(b.x)], 1u);
            asm volatile("s_waitcnt vmcnt(0)" ::: "memory");
        } else {
            XB_SPIN(xb_ld(&bar[XB_XGEN(b.x)]) == gen, bar);
            __builtin_amdgcn_fence(__ATOMIC_ACQUIRE, "agent");
            asm volatile("s_waitcnt vmcnt(0)" ::: "memory");
        }
    }
    __syncthreads();
}

#ifndef MK_REP_MASK
#define MK_REP_MASK 0
#endif
template <int PH> __device__ __forceinline__ void run_phase(const Args& a, LAS unsigned char* lds, int tid_in, int wave_in, int lane_in) {
    typedef pg8::bf16_t pb;
    int tid = threadIdx.x; asm volatile("" : "+v"(tid)); const int lane = tid & 63, wave = __builtin_amdgcn_readfirstlane(tid >> 6);
    (void)tid_in; (void)wave_in; (void)lane_in;
    const int G = gridDim.x, bx = blockIdx.x;
    unsigned char* ws = a.ws;
    if constexpr (PH == 0) p0_prologue(a, lds, tid, wave, lane);
    if constexpr (PH == 1) p1_modulate(a, wave, lane);
    if constexpr (PH == 2) {
        pg8::Gemm g{(const pb*)(ws + WS_H), (const pb*)(ws + WS_WIN), MROWS, INW, DM, LDK}; pg8::GridOrder<1> S; S.init(128, 24, G, bx);
        pg8::EpiIn E{(pb*)(ws + WS_P), (const pg8::f32x2*)(ws + WS_ROPE), (pb*)(ws + WS_VT), (pb*)(ws + WS_VTC), (pb*)(ws + WS_KN), (pb*)(ws + WS_KNC)};
        pg8::gemm_phase<pg8::EpiIn, pg8::GridOrder<1>, false, true, false>(lds, g, S, E);
    }
    if constexpr (PH == 3) { for (int it = bx; it < 256; it += G) r1_block(a, lds, it, tid, wave, lane); }
    if constexpr (PH == 4) {
#pragma unroll 1
        for (int L = bx; L < 1024; L += G) {
            const int id = (L & 7) * 128 + (L >> 3), bh = id >> 3, rq = id & 7, b = bh >> 3, h = bh & 7;
            {
                const GAS char* ksrc = (const GAS char*)(ws + WS_KNC) + (size_t)(b * 8 + h) * 65536; const GAS char* vsrc = (const GAS char*)(ws + WS_VTC) + (size_t)(b * 8 + h) * 65536;
                bf16x8 kv[8], vv[8];
#pragma unroll
                for (int j = 0; j < 8; ++j) { const int idx = tid + NTHR * j; kv[j] = *(const GAS bf16x8*)(ksrc + (size_t)idx * 16); vv[j] = *(const GAS bf16x8*)(vsrc + (size_t)idx * 16); }
#pragma unroll
                for (int j = 0; j < 8; ++j) { const int idx = tid + NTHR * j, key = (idx >> 7) * 8 + ((idx >> 2) & 7), dch = ((idx >> 5) & 3) * 4 + (idx & 3);
                    *(LAS bf16x8*)(lds + NA_KC_OFF + key * NA_KC_PITCH + 16 * dch) = kv[j]; }
#pragma unroll
                for (int j = 0; j < 8; ++j) { const int idx = tid + NTHR * j, gr = idx >> 7, vd = idx & 127; *(LAS bf16x8*)(lds + NA_VC_OFF + vd * NA_VC_PITCH + 16 * gr) = vv[j]; }
                LAS float* rpbs = (LAS float*)(lds + NA_RPB_OFF);
                if (tid < 15 * 31) rpbs[tid] = a.in[11][h * 15 * 31 + tid];
            }
            __syncthreads();
            { int ln = lane; asm volatile("" : "+v"(ln)); na_wave(a, lds, b, h, 4 * rq + 2 * (wave >> 2), wave & 3, ln); }
            __syncthreads();
        }
#pragma unroll 1
        for (int t = bx; t < 256; t += G) {
            const int bh = (t & 7) * 16 + (t >> 4), half = (t >> 3) & 1, b = bh >> 3, h = bh & 7;
            R2Regs rr; r2_load(a, rr, b, h, half * 8, tid);
#pragma unroll 1
            for (int i = 0; i < 8; ++i) { const int c = half * 8 + i;
                r2_store(rr, lds, tid);
                __syncthreads();
                if (i + 1 < 8) r2_load(a, rr, b, h, c + 1, tid);
                { int ln = lane; asm volatile("" : "+v"(ln)); r2_wave(a, lds, b, h, c, wave, ln); }
                __syncthreads(); }
        }
    }
    if constexpr (PH == 5) { pg8::Gemm g{(const pb*)(ws + WS_MIX), (const pb*)(ws + WS_WOUT), NTOK, DM, DM, LDK}; pg8::GridOrder<0, 4> S; S.init(128, 8, G, bx);
        pg8::EpiPlain E{(pb*)(ws + WS_Y), DM}; pg8::gemm_phase<pg8::EpiPlain, pg8::GridOrder<0, 4>, false, true, false>(lds, g, S, E); }
    if constexpr (PH == 6) p6_rows(a, wave, lane);
    if constexpr (PH == 7) { pg8::Gemm g{(const pb*)(ws + WS_H), (const pb*)(ws + WS_WGU), NTOK, NGU, DM, LDK}; pg8::GridOrder<0> S; S.init(128, 44, G, bx);
        pg8::EpiSwiglu E{(pb*)(ws + WS_HID), LDF}; pg8::gemm_phase<pg8::EpiSwiglu, pg8::GridOrder<0>, false, true, false>(lds, g, S, E); }
    if constexpr (PH == 8) { pg8::Gemm g{(const pb*)(ws + WS_HID), (const pb*)(ws + WS_WD), NTOK, DM, DFF, LDF}; pg8::GridOrder<0, 4, true> S; S.init(128, 8, G, bx);
        pg8::EpiPlain E{(pb*)(ws + WS_MIX), DM}; pg8::gemm_phase<pg8::EpiPlain, pg8::GridOrder<0, 4, true>, false, true, false>(lds, g, S, E); }
    if constexpr (PH == 9) p9_rows(a, wave, lane);
}
template <bool CG_SEAM, int FIRST, int... REST> __device__ __forceinline__ void run_prog(const Args& a, LAS unsigned char* lds, const XcdBarrier& bar, int tid, int wave, int lane) {
    if constexpr ((MK_REP_MASK >> FIRST) & 1) {
#pragma unroll 1
        for (int rep = 0; rep < a.pad0; ++rep) { if (rep) xcd_barrier(bar); run_phase<FIRST>(a, lds, tid, wave, lane); }
    } else run_phase<FIRST>(a, lds, tid, wave, lane);
    if constexpr (sizeof...(REST) > 0) {
        xcd_barrier(bar);
        if constexpr (CG_SEAM) { if (a.pad1 == 0x5eed) cg::this_grid().sync(); }
        run_prog<false, REST...>(a, lds, bar, tid, wave, lane); }
}
#ifndef MK_PROG
#define MK_PROG 0, 1, 2, 3, 4, 5, 6, 7, 8, 9
#endif
__global__ void __launch_bounds__(NTHR, 2) fwd_kernel(Args a) {
    extern __shared__ __attribute__((aligned(16))) unsigned char lds_raw[];
    LAS unsigned char* lds = (LAS unsigned char*)lds_raw;
    const int tid = threadIdx.x, lane = tid & 63, wave = __builtin_amdgcn_readfirstlane(tid >> 6);
    volatile LAS unsigned* st = (volatile LAS unsigned*)(lds + LDS_BARST_OFF);
    if (tid < 2) st[tid] = 0u;
    __syncthreads();
    const XcdBarrier bar = xcd_barrier_post((unsigned*)(a.ws + WS_BAR), st);
    run_prog<true, MK_PROG>(a, lds, bar, tid, wave, lane);
}

template <int PH> __global__ void __launch_bounds__(NTHR, 2) phase_kernel(Args a) {
    extern __shared__ __attribute__((aligned(16))) unsigned char lds_raw[];
    LAS unsigned char* lds = (LAS unsigned char*)lds_raw;
    const int tid = threadIdx.x, lane = tid & 63, wave = __builtin_amdgcn_readfirstlane(tid >> 6);
    run_phase<PH>(a, lds, tid, wave, lane);
}
#ifndef MK_PROBE_MASK
#define MK_PROBE_MASK 0
#endif
template <int PH> static void launch_phase(const Args& a, int grid, void* d_ws, hipStream_t stream) {
    const int n = ((MK_PROBE_MASK >> PH) & 1) ? 2 : 1;
    for (int r = 0; r < n; ++r) {
        if (PH == 0) (void)hipMemsetAsync((char*)d_ws + WS_M, 0, WS_M_BYTES, stream);
        (void)hipFuncSetAttribute((const void*)phase_kernel<PH>, hipFuncAttributeMaxDynamicSharedMemorySize, LDS_BYTES);
        hipLaunchKernelGGL(phase_kernel<PH>, dim3(grid), dim3(NTHR), LDS_BYTES, stream, a);
    }
}
extern "C" void kernel_launch(void* const* d_in, const int* in_sizes, int n_in, void* d_out, int out_size, void* d_ws, size_t ws_size, hipStream_t stream) {
    static int grid = 0;
    if (grid == 0) {
        if (n_in != 18 || out_size != NTOK * DM || ws_size < WS_END) { fprintf(stderr, "kernel_launch: unexpected shapes (n_in %d out %d ws %zu)\n", n_in, out_size, ws_size); grid = -1; return; }
        int dev = 0, cus = 0, per_cu = 0;
        (void)hipGetDevice(&dev); (void)hipDeviceGetAttribute(&cus, hipDeviceAttributeMultiprocessorCount, dev);
        if (hipFuncSetAttribute((const void*)fwd_kernel, hipFuncAttributeMaxDynamicSharedMemorySize, LDS_BYTES) != hipSuccess) { fprintf(stderr, "kernel_launch: hipFuncSetAttribute failed\n"); grid = -1; return; }
        if (hipOccupancyMaxActiveBlocksPerMultiprocessor(&per_cu, (const void*)fwd_kernel, NTHR, LDS_BYTES) != hipSuccess || per_cu < 1) { fprintf(stderr, "kernel_launch: occupancy query says %d\n", per_cu); per_cu = 1; }
        (void)hipGetLastError();
        grid = cus > 0 ? cus : 256;
        if (grid % 8 != 0) grid -= grid % 8;
    }
    if (grid < 0) return;
    (void)hipMemsetAsync((char*)d_ws, 0, WS_ZERO_BYTES, stream);
    Args a{};
    for (int i = 0; i < 18; ++i) a.in[i] = (const float*)d_in[i];
    a.out = (float*)d_out; a.ws = (unsigned char*)d_ws; a.pad0 = 2;
#if MK_PROBE_MASK != 0
    launch_phase<0>(a, grid, d_ws, stream); launch_phase<1>(a, grid, d_ws, stream); launch_phase<2>(a, grid, d_ws, stream); launch_phase<3>(a, grid, d_ws, stream); launch_phase<4>(a, grid, d_ws, stream);
    launch_phase<5>(a, grid, d_ws, stream); launch_phase<6>(a, grid, d_ws, stream); launch_phase<7>(a, grid, d_ws, stream);
    launch_phase<8>(a, grid, d_ws, stream); launch_phase<9>(a, grid, d_ws, stream);
    return;
#endif
    void* args[] = {&a};
    hipError_t e = hipLaunchCooperativeKernel((const void*)fwd_kernel, dim3(grid), dim3(NTHR), args, LDS_BYTES, stream);
    if (e != hipSuccess) fprintf(stderr, "kernel_launch: cooperative launch failed: %s (grid %d)\n", hipGetErrorString(e), grid);
}
```
